# Optimizing an MI355X kernel written in HIP

```python
import jax
import jax.numpy as jnp
from jax import lax
import numpy as np

D_MODEL = 2048
BATCH = 1
SEQ = 8192
DEPTH = 2

HEAD_DIM = 128
ROPE_THETA = 10000.0
ATTN_SCALE = HEAD_DIM ** -0.5
QB = 128
NEG = -1e30
TINY = 1e-30

DIL_PATTERNS = ((128, 1), (512, 4), (2048, 16))
A_HEADS_PER_GROUP = 4
A_HEADS = A_HEADS_PER_GROUP * len(DIL_PATTERNS)
B_HEADS = 4
C_HEADS = 4
IDX_HEADS = 16
IDX_DIM = 64
DSA_TOPK = 256
D_HEADS = 4
CMP_LEN = 32
CMP_STRIDE = 16
CMP_HIDDEN = 256
SLC_BLOCK = 64
SLC_COUNT = 16
WIN = 512
FORCE = 1e9
N_BRANCH = 4
BRANCH_WIDTH = 4 * HEAD_DIM
FFN_CEIL = -(-8 * D_MODEL // 3)
FFN_HIDDEN = -(-FFN_CEIL // 256) * 256

IN_SPLITS = (
    A_HEADS * HEAD_DIM, A_HEADS * HEAD_DIM, A_HEADS * HEAD_DIM,
    B_HEADS * HEAD_DIM, B_HEADS * HEAD_DIM, B_HEADS * HEAD_DIM, B_HEADS,
    C_HEADS * HEAD_DIM, C_HEADS * HEAD_DIM, C_HEADS * HEAD_DIM,
    IDX_HEADS * IDX_DIM, IDX_DIM, IDX_HEADS,
    D_HEADS * HEAD_DIM,
    HEAD_DIM, HEAD_DIM, HEAD_DIM, HEAD_DIM, HEAD_DIM, HEAD_DIM,
    3 * D_HEADS,
)
IN_COLS = sum(IN_SPLITS)

kernel_name = 'hybrid_gated_dilated_fox_dsa_nsa_block'


def rms_norm(x, g, eps=1e-6):
    xf = x.astype(jnp.float32)
    y = xf * lax.rsqrt(jnp.mean(xf * xf, axis=-1, keepdims=True) + eps)
    return (y * g.astype(jnp.float32)).astype(x.dtype)


def rope(x, pos):
    half = x.shape[-1] // 2
    inv_freq = ROPE_THETA ** (-jnp.arange(half, dtype=jnp.float32) / half)
    ang = pos.astype(jnp.float32)[:, None] * inv_freq[None, :]
    cos = jnp.cos(ang)[None, :, None, :]
    sin = jnp.sin(ang)[None, :, None, :]
    x1 = x[..., :half].astype(jnp.float32)
    x2 = x[..., half:].astype(jnp.float32)
    return jnp.concatenate([x1 * cos - x2 * sin, x2 * cos + x1 * sin], axis=-1).astype(x.dtype)


def masked_softmax(logits, mask):
    logits = jnp.where(mask, logits.astype(jnp.float32), NEG)
    m = jnp.max(logits, axis=-1, keepdims=True)
    p = jnp.where(mask, jnp.exp(logits - m), 0.0)
    s = jnp.maximum(jnp.sum(p, axis=-1, keepdims=True), TINY)
    return p / s, (m + jnp.log(s))[..., 0]


def sweep_query_blocks(fn, seq_len):
    out = lax.map(fn, jnp.arange(seq_len // QB))
    out = jnp.moveaxis(out, 0, 1)
    return out.reshape((out.shape[0], seq_len) + out.shape[3:])


def dilated_group(q, k, v, window, dilation):
    B, S, H, Dh = q.shape
    span = window // dilation
    L = S // dilation
    nb = -(-L // QB)
    Lp = nb * QB

    def to_blocks(a):
        a = a.reshape(B, L, dilation, H, Dh).transpose(0, 2, 1, 3, 4)
        a = jnp.pad(a, ((0, 0), (0, 0), (0, Lp - L), (0, 0), (0, 0)))
        return a.reshape(B, dilation, nb, QB, H, Dh)

    def with_prev(a):
        prev = jnp.pad(a, ((0, 0), (0, 0), (1, 0), (0, 0), (0, 0), (0, 0)))[:, :, :-1]
        return jnp.concatenate([prev, a], axis=3)

    qb = to_blocks(q)
    kb = with_prev(to_blocks(k))
    vb = with_prev(to_blocks(v))
    logits = jnp.einsum('brnqhd,brnkhd->brnhqk', qb, kb).astype(jnp.float32) * ATTN_SCALE
    qi = jnp.arange(QB)[:, None]
    ki = jnp.arange(2 * QB)[None, :]
    dist = QB + qi - ki
    band = (dist >= 0) & (dist <= span)
    has_prev = (jnp.arange(nb) > 0)[:, None, None] | (ki >= QB)[None]
    mask = (band[None] & has_prev)[None, None, :, None]
    probs, lse = masked_softmax(logits, mask)
    out = jnp.einsum('brnhqk,brnkhd->brnqhd', probs.astype(v.dtype), vb)
    out = out.reshape(B, dilation, Lp, H, Dh)[:, :, :L].transpose(0, 2, 1, 3, 4).reshape(B, S, H, Dh)
    lse = lse.transpose(0, 1, 2, 4, 3).reshape(B, dilation, Lp, H)[:, :, :L]
    lse = lse.transpose(0, 2, 1, 3).reshape(B, S, H)
    return out, lse


def mixer_a(q, k, v):
    outs, lses = [], []
    for g, (window, dilation) in enumerate(DIL_PATTERNS):
        sl = slice(g * A_HEADS_PER_GROUP, (g + 1) * A_HEADS_PER_GROUP)
        o, l = dilated_group(q[:, :, sl], k[:, :, sl], v[:, :, sl], window, dilation)
        outs.append(o)
        lses.append(l)
    wts = jax.nn.softmax(jnp.stack(lses, axis=0), axis=0)
    return jnp.einsum('gbsh,gbshd->bshd', wts.astype(v.dtype), jnp.stack(outs, axis=0))


def mixer_b(q, k, v, f_logit):
    B, S, H, Dh = q.shape
    c = lax.cumsum(jax.nn.log_sigmoid(f_logit.astype(jnp.float32)), axis=1)
    c_k = c.transpose(0, 2, 1)[:, :, None, :]
    kpos = jnp.arange(S)

    def block(b):
        q0 = b * QB
        qb = lax.dynamic_slice_in_dim(q, q0, QB, axis=1)
        cb = lax.dynamic_slice_in_dim(c, q0, QB, axis=1).transpose(0, 2, 1)[..., None]
        logits = jnp.einsum('bqhd,bkhd->bhqk', qb, k).astype(jnp.float32) * ATTN_SCALE + cb - c_k
        mask = (q0 + jnp.arange(QB))[:, None] >= kpos[None, :]
        probs, _ = masked_softmax(logits, mask)
        return jnp.einsum('bhqk,bkhd->bqhd', probs.astype(v.dtype), v)

    return sweep_query_blocks(block, S)


def mixer_c(q, k, v, q_idx, k_idx, w_idx):
    B, S, H, Dh = q.shape
    topk = min(DSA_TOPK, S // 4)
    kpos = jnp.arange(S)
    bi = jnp.arange(B)[:, None, None]

    def block(b):
        q0 = b * QB
        qpos = q0 + jnp.arange(QB)
        qib = lax.dynamic_slice_in_dim(q_idx, q0, QB, axis=1)
        wib = lax.dynamic_slice_in_dim(w_idx, q0, QB, axis=1).astype(jnp.float32) * IDX_HEADS ** -0.5
        rel = jax.nn.relu(jnp.einsum('bqhe,bke->bqhk', qib, k_idx).astype(jnp.float32) * IDX_DIM ** -0.5)
        score = jnp.einsum('bqh,bqhk->bqk', wib, rel)
        score = jnp.where((kpos[None, :] <= qpos[:, None])[None], score, NEG)
        _, idx = lax.top_k(score, topk)
        ks = k[bi, idx]
        vs = v[bi, idx]
        qb = lax.dynamic_slice_in_dim(q, q0, QB, axis=1)
        logits = jnp.einsum('bqhd,bqkhd->bqhk', qb, ks).astype(jnp.float32) * ATTN_SCALE
        valid = (idx <= qpos[None, :, None])[:, :, None, :]
        probs, _ = masked_softmax(logits, valid)
        return jnp.einsum('bqhk,bqkhd->bqhd', probs.astype(v.dtype), vs)

    return sweep_query_blocks(block, S)


def compress(x, pe, w1, w2):
    B, S, Dh = x.shape
    nc = (S - CMP_LEN) // CMP_STRIDE + 1
    idx = jnp.arange(nc)[:, None] * CMP_STRIDE + jnp.arange(CMP_LEN)[None, :]
    blocks = (x[:, idx] + pe).reshape(B, nc, CMP_LEN * Dh)
    return jax.nn.gelu(blocks @ w1) @ w2


def mixer_d(q, kc, vc, ks, vs, kw, vw, gate_logit, pe, w1, w2):
    B, S, H, Dh = q.shape
    k_cmp = compress(kc, pe[0], w1[0], w2[0])
    v_cmp = compress(vc, pe[1], w1[1], w2[1])
    nc = k_cmp.shape[1]
    cmp_end = jnp.arange(nc) * CMP_STRIDE + CMP_LEN - 1
    n_slc = S // SLC_BLOCK
    n_sel = min(SLC_COUNT, n_slc)
    ci = jnp.arange(nc)[:, None]
    sj = jnp.arange(n_slc)[None, :]
    overlap = ((ci * CMP_STRIDE < (sj + 1) * SLC_BLOCK) &
               (ci * CMP_STRIDE + CMP_LEN > sj * SLC_BLOCK)).astype(jnp.float32)
    ks_blk = ks.reshape(B, n_slc, SLC_BLOCK, Dh)
    vs_blk = vs.reshape(B, n_slc, SLC_BLOCK, Dh)
    kw_pad = jnp.pad(kw, ((0, 0), (WIN, 0), (0, 0)))
    vw_pad = jnp.pad(vw, ((0, 0), (WIN, 0), (0, 0)))
    gates = jax.nn.sigmoid(gate_logit.astype(jnp.float32))
    bi = jnp.arange(B)[:, None, None]
    jpos = jnp.arange(n_slc)[None, :]

    def block(b):
        q0 = b * QB
        qpos = q0 + jnp.arange(QB)
        qb = lax.dynamic_slice_in_dim(q, q0, QB, axis=1)
        lc = jnp.einsum('bqhd,bnd->bqhn', qb, k_cmp).astype(jnp.float32) * ATTN_SCALE
        mc = (cmp_end[None, :] <= qpos[:, None])[None, :, None, :]
        pc, _ = masked_softmax(lc, mc)
        o_cmp = jnp.einsum('bqhn,bnd->bqhd', pc.astype(qb.dtype), v_cmp)
        imp = jnp.einsum('bqhn,nj->bqj', pc, overlap)
        cur = (qpos // SLC_BLOCK)[:, None]
        admissible = jpos * SLC_BLOCK <= qpos[:, None]
        forced = (jpos == 0) | (jpos == cur) | (jpos == cur - 1)
        imp = jnp.where(forced[None], FORCE, jnp.where(admissible[None], imp, NEG))
        _, sel = lax.top_k(imp, n_sel)
        kg = ks_blk[bi, sel]
        vg = vs_blk[bi, sel].reshape(B, QB, n_sel * SLC_BLOCK, Dh)
        ls = jnp.einsum('bqhd,bqnld->bqhnl', qb, kg).astype(jnp.float32) * ATTN_SCALE
        ls = ls.reshape(B, QB, H, n_sel * SLC_BLOCK)
        tokpos = sel[..., None] * SLC_BLOCK + jnp.arange(SLC_BLOCK)
        ms = (tokpos <= qpos[None, :, None, None]).reshape(B, QB, 1, n_sel * SLC_BLOCK)
        ps, _ = masked_softmax(ls, ms)
        o_slc = jnp.einsum('bqhk,bqkd->bqhd', ps.astype(qb.dtype), vg)
        kwb = lax.dynamic_slice_in_dim(kw_pad, q0, QB + WIN, axis=1)
        vwb = lax.dynamic_slice_in_dim(vw_pad, q0, QB + WIN, axis=1)
        lw = jnp.einsum('bqhd,bkd->bqhk', qb, kwb).astype(jnp.float32) * ATTN_SCALE
        kpos = q0 - WIN + jnp.arange(QB + WIN)
        dist = qpos[:, None] - kpos[None, :]
        mw = ((dist >= 0) & (dist < WIN) & (kpos[None, :] >= 0))[None, :, None, :]
        pw, _ = masked_softmax(lw, mw)
        o_win = jnp.einsum('bqhk,bkd->bqhd', pw.astype(qb.dtype), vwb)
        gb = lax.dynamic_slice_in_dim(gates, q0, QB, axis=1)
        out = gb[..., 0:1] * o_cmp + gb[..., 1:2] * o_slc + gb[..., 2:3] * o_win
        return out.astype(qb.dtype)

    return sweep_query_blocks(block, S)


def hybrid_layer(x, norm_mix, w_in, w_gate, b_gate, b_f, cmp_pe, cmp_w1, cmp_w2,
                 w_branch, w_out, norm_ffn, w_ffn_in, w_ffn_out):
    B, S, _ = x.shape
    pos = jnp.arange(S)
    h = rms_norm(x, norm_mix)
    (aq, ak, av, bq, bk, bv, bfl, cq, ck, cv, cqi, cki, cwi,
     dq, dkc, dvc, dks, dvs, dkw, dvw, dg) = jnp.split(
        h @ w_in, np.cumsum(IN_SPLITS)[:-1].tolist(), axis=-1)

    def heads(t):
        return t.reshape(B, S, -1, HEAD_DIM)

    def rope1(t):
        return rope(t[:, :, None, :], pos)[:, :, 0]

    o_a = mixer_a(rope(heads(aq), pos), rope(heads(ak), pos), heads(av))
    o_b = mixer_b(heads(bq), heads(bk), heads(bv), bfl + b_f)
    o_c = mixer_c(rope(heads(cq), pos), rope(heads(ck), pos), heads(cv),
                  rope(cqi.reshape(B, S, IDX_HEADS, IDX_DIM), pos), rope1(cki), cwi)
    o_d = mixer_d(rope(heads(dq), pos), rope1(dkc), dvc, rope1(dks), dvs, rope1(dkw), dvw,
                  dg.reshape(B, S, D_HEADS, 3), cmp_pe, cmp_w1, cmp_w2)

    branches = jnp.stack([o_a, o_b, o_c, o_d], axis=2).reshape(B, S, N_BRANCH, BRANCH_WIDTH)
    y = jnp.einsum('bsnc,ncd->bsnd', branches, w_branch)
    g = jax.nn.sigmoid(jnp.einsum('bsd,dne->bsne', h, w_gate) + b_gate)
    x = x + jnp.einsum('bsnd,bsnd->bsd', g, y) @ w_out

    h2 = rms_norm(x, norm_ffn)
    gate, up = jnp.split(h2 @ w_ffn_in, 2, axis=-1)
    return x + (jax.nn.silu(gate) * up) @ w_ffn_out


def setup_inputs(seed: int = 0) -> dict:
    key = jax.random.key(seed)
    ks = jax.random.split(key, 16)

    def dense(k, shape, fan_in):
        return jax.random.normal(k, shape, jnp.float32) * fan_in ** -0.5

    def gain(k, shape):
        return 1.0 + 0.05 * jax.random.normal(k, shape, jnp.float32)

    return {
        'x': jax.random.normal(ks[0], (BATCH, SEQ, D_MODEL), jnp.float32),
        'norm_mix': gain(ks[1], (DEPTH, D_MODEL)),
        'w_in': dense(ks[2], (DEPTH, D_MODEL, IN_COLS), D_MODEL),
        'w_gate': dense(ks[3], (DEPTH, D_MODEL, N_BRANCH, D_MODEL), D_MODEL),
        'b_gate': 0.02 * jax.random.normal(ks[4], (DEPTH, N_BRANCH, D_MODEL), jnp.float32),
        'b_f': 3.0 + 0.1 * jax.random.normal(ks[5], (DEPTH, B_HEADS), jnp.float32),
        'cmp_pe': 0.1 * jax.random.normal(ks[6], (DEPTH, 2, CMP_LEN, HEAD_DIM), jnp.float32),
        'cmp_w1': dense(ks[7], (DEPTH, 2, CMP_LEN * HEAD_DIM, CMP_HIDDEN), CMP_LEN * HEAD_DIM),
        'cmp_w2': dense(ks[8], (DEPTH, 2, CMP_HIDDEN, HEAD_DIM), CMP_HIDDEN),
        'w_branch': dense(ks[9], (DEPTH, N_BRANCH, BRANCH_WIDTH, D_MODEL), BRANCH_WIDTH),
        'w_out': dense(ks[10], (DEPTH, D_MODEL, D_MODEL), D_MODEL),
        'norm_ffn': gain(ks[11], (DEPTH, D_MODEL)),
        'w_ffn_in': dense(ks[12], (DEPTH, D_MODEL, 2 * FFN_HIDDEN), D_MODEL),
        'w_ffn_out': dense(ks[13], (DEPTH, FFN_HIDDEN, D_MODEL), FFN_HIDDEN),
        'norm_final': gain(ks[14], (D_MODEL,)),
    }


def reference(x, norm_mix, w_in, w_gate, b_gate, b_f, cmp_pe, cmp_w1, cmp_w2,
              w_branch, w_out, norm_ffn, w_ffn_in, w_ffn_out, norm_final):
    for l in range(DEPTH):
        x = hybrid_layer(x, norm_mix[l], w_in[l], w_gate[l], b_gate[l], b_f[l],
                         cmp_pe[l], cmp_w1[l], cmp_w2[l], w_branch[l], w_out[l],
                         norm_ffn[l], w_ffn_in[l], w_ffn_out[l])
    return rms_norm(x, norm_final)
```

```cpp
#include <hip/hip_runtime.h>
#include <cstdio>
#include <cstdint>
namespace pg8 {
#define PG8_LAS __attribute__((address_space(3)))
typedef unsigned short bf16_t;
typedef short bf16x8 __attribute__((ext_vector_type(8)));
typedef float f32x4 __attribute__((ext_vector_type(4)));
typedef unsigned u32x4 __attribute__((ext_vector_type(4)));
constexpr int BM = 256, BK = 64, HALF = 128, HTB = HALF * BK * 2  , STAGE_BYTES = 8 * HTB, NXCD = 8, WGM = 8;

__host__ __device__ __forceinline__ int lds_byte(int r, int c) { const int st = (r >> 4) * 2 + (c >> 5), rr = r & 15, cc = c & 31, ob = rr * 64 + cc * 2; return st * 1024 + (ob ^ (((ob >> 9) & 1) << 5)); }
__host__ __device__ __forceinline__ void stage_rc(int b, int& R, int& C) { const int st = b / 1024, sb = b % 1024, swz = sb ^ (((sb >> 9) & 1) << 5); R = (st >> 1) * 16 + swz / 64; C = (st & 1) * 32 + (swz % 64) / 2; }
__host__ __device__ __forceinline__ int perm32(int rho) { const int n = rho >> 4, i = rho & 15; return 8 * (i >> 2) + 4 * n + (i & 3); }

struct Unit { int pm, pn; };
struct Gemm { const bf16_t* A; const bf16_t* Bt; int M, N, K; };

struct StaticOrder {
    int nM, nN, nwg, G, c;
    __host__ __device__ void init(int M, int N, int G_, int c_) { nM = M / BM; nN = N / BM; nwg = nM * nN; G = G_; c = c_; }
    __host__ __device__ bool next(int i, Unit& u) const {
        const long L = (long)i * G + c; if (L >= nwg) return false;
        int wgid = (int)L; { const int q = nwg / NXCD, r = nwg % NXCD, xcd = wgid % NXCD, off = wgid / NXCD; wgid = (xcd < r ? xcd * (q + 1) : r * (q + 1) + (xcd - r) * q) + off; }
        const int nig = WGM * nN, gid = wgid / nig, fm = gid * WGM, gsz = (nM - fm) < WGM ? (nM - fm) : WGM;
        u.pm = fm + ((wgid % nig) % gsz); u.pn = (wgid % nig) / gsz; return true;
    }
    __device__ __forceinline__ void a_ready(const Unit&) const {}
    __device__ __forceinline__ void done(const Unit&) const {}
};

__device__ __forceinline__ unsigned cvt_pk_bf16(float lo, float hi) { unsigned r; asm volatile("v_cvt_pk_bf16_f32 %0, %1, %2" : "=v"(r) : "v"(lo), "v"(hi)); return r; }
typedef float f32x2 __attribute__((ext_vector_type(2)));
template <class Epi, class Sched, bool ALIGN_EPI = false, bool SP2 = false>
__device__ __forceinline__ void gemm_phase(PG8_LAS unsigned char* lds, const Gemm g, const Sched& S, const Epi& E) {
    int tid_ = threadIdx.x; asm volatile("" : "+v"(tid_));
    const int tid = tid_, wid = __builtin_amdgcn_readfirstlane(tid >> 6), lane = tid & 63, wr = wid >> 2, wc = wid & 3, fr = lane & 15, fq = lane >> 4;
    const int K = g.K, nt = K / BK;
    unsigned voffA[2], voffB[2];
#pragma unroll
    for (int i = 0; i < 2; ++i) { int R, C; stage_rc(tid * 16 + i * 8192, R, C); const int Rb = Epi::PERM ? ((R & ~31) + perm32(R & 31)) : R;
        voffA[i] = (unsigned)(R * K + C) * 2u; voffB[i] = (unsigned)(Rb * K + C) * 2u; }
    const size_t kstep = (size_t)(BK * 2);
    const size_t hstep = (size_t)HALF * K * 2;
    const size_t tstep = 2 * hstep;
    const unsigned ldsw = (unsigned)wid * 1024u;
    const int aoff = lds_byte(wr * 64 + fr, fq * 8), boff = lds_byte(wc * 32 + fr, fq * 8);
#define PG8_SA(b, h) (((b) * 2 + (h)) * HTB)
#define PG8_SB(b, h) ((4 + (b) * 2 + (h)) * HTB)
#define PG8_STAGE(bufoff, gbase, voff) do { _Pragma("unroll") for (int _i = 0; _i < 2; ++_i) \
        __builtin_amdgcn_global_load_lds((const unsigned*)((const char*)(gbase) + (voff)[_i]), (PG8_LAS unsigned*)(lds + (bufoff) + ldsw + _i * 8192), 16, 0, 0); } while (0)
#define PG8_LDA(dst, b, h) do { _Pragma("unroll") for (int m = 0; m < 4; ++m) _Pragma("unroll") for (int k = 0; k < 2; ++k) dst[m][k] = *(const PG8_LAS bf16x8*)(lds + PG8_SA(b, h) + aoff + m * 2048 + k * 1024); } while (0)
#define PG8_LDB(dst, b, h) do { _Pragma("unroll") for (int n = 0; n < 2; ++n) _Pragma("unroll") for (int k = 0; k < 2; ++k) dst[n][k] = *(const PG8_LAS bf16x8*)(lds + PG8_SB(b, h) + boff + n * 2048 + k * 1024); } while (0)
#define PG8_MMA(ai, bj, At, Bt) do { __builtin_amdgcn_s_setprio(1); _Pragma("unroll") for (int m = 0; m < 4; ++m) _Pragma("unroll") for (int n = 0; n < 2; ++n) _Pragma("unroll") for (int k = 0; k < 2; ++k) \
        acc[ai][bj][m][n] = __builtin_amdgcn_mfma_f32_16x16x32_bf16(Bt[n][k], At[m][k], acc[ai][bj][m][n], 0, 0, 0); __builtin_amdgcn_s_setprio(0); } while (0)
#define PG8_WAIT_V(n) asm volatile("s_waitcnt vmcnt(" #n ")" ::: "memory")
#define PG8_WAIT_L(n) asm volatile("s_waitcnt lgkmcnt(" #n ")" ::: "memory")
#define PG8_BAR __builtin_amdgcn_s_barrier()
#define PG8_SCHED __builtin_amdgcn_sched_barrier(0)
    Unit cur, nxt; int ui = 0;
    if (!S.next(0, cur)) return;
    f32x4 acc[2][2][4][2];
#pragma unroll
    for (int a = 0; a < 2; ++a)
#pragma unroll
        for (int b = 0; b < 2; ++b)
#pragma unroll
            for (int m = 0; m < 4; ++m)
#pragma unroll
                for (int n = 0; n < 2; ++n) acc[a][b][m][n] = (f32x4){0.f, 0.f, 0.f, 0.f};
    bf16x8 At[4][2], B0[2][2], B1[2][2];
    const char* cA = (const char*)g.A + (size_t)cur.pm * tstep; const char* cB = (const char*)g.Bt + (size_t)cur.pn * tstep;
    S.a_ready(cur);
    if constexpr (SP2) {
        PG8_STAGE(PG8_SB(0, 0), cB, voffB); PG8_STAGE(PG8_SB(0, 1), cB + hstep, voffB); PG8_STAGE(PG8_SA(0, 0), cA, voffA); PG8_STAGE(PG8_SA(0, 1), cA + hstep, voffA);
        if (wr == 1) PG8_BAR;
        PG8_WAIT_V(2); PG8_BAR;
        PG8_STAGE(PG8_SB(1, 0), cB + kstep, voffB); PG8_STAGE(PG8_SA(1, 0), cA + kstep, voffA); PG8_STAGE(PG8_SB(1, 1), cB + hstep + kstep, voffB);
        PG8_WAIT_V(6); PG8_BAR;
    } else {
        PG8_STAGE(PG8_SB(0, 0), cB, voffB); PG8_STAGE(PG8_SA(0, 0), cA, voffA); PG8_STAGE(PG8_SB(0, 1), cB + hstep, voffB); PG8_STAGE(PG8_SA(0, 1), cA + hstep, voffA);
        if (wr == 1) PG8_BAR;
        PG8_WAIT_V(4); PG8_BAR;
        PG8_STAGE(PG8_SB(1, 0), cB + kstep, voffB); PG8_STAGE(PG8_SA(1, 0), cA + kstep, voffA); PG8_STAGE(PG8_SB(1, 1), cB + hstep + kstep, voffB);
        PG8_WAIT_V(6); PG8_BAR;
    }
    for (;;) {
        const bool has_next = S.next(ui + 1, nxt);
        const char* nA = has_next ? (const char*)g.A + (size_t)nxt.pm * tstep : cA; const char* nB = has_next ? (const char*)g.Bt + (size_t)nxt.pn * tstep : cB;
        for (int t = 0; t < nt; t += 2) {
            const bool last = (t == nt - 2);
            const char* a1 = cA + (size_t)(t + 1) * kstep;
            const char* a2 = last ? nA : cA + (size_t)(t + 2) * kstep; const char* b2 = last ? nB : cB + (size_t)(t + 2) * kstep;
            const char* a3 = a2 + kstep; const char* b3 = b2 + kstep;
            if (last && has_next) S.a_ready(nxt);
            if constexpr (SP2) {
            PG8_LDB(B0, 0, 0); PG8_LDB(B1, 0, 1); PG8_SCHED; PG8_LDA(At, 0, 0); PG8_STAGE(PG8_SA(1, 1), a1 + hstep, voffA);
            PG8_WAIT_V(8); PG8_WAIT_L(0); PG8_BAR; PG8_MMA(0, 0, At, B0); PG8_MMA(0, 1, At, B1); PG8_BAR; PG8_SCHED;
            PG8_LDA(At, 0, 1); PG8_STAGE(PG8_SB(0, 0), b2, voffB); PG8_STAGE(PG8_SB(0, 1), b2 + hstep, voffB); PG8_STAGE(PG8_SA(0, 0), a2, voffA);
            PG8_WAIT_V(8); PG8_WAIT_L(0); PG8_BAR; PG8_MMA(1, 0, At, B0); PG8_MMA(1, 1, At, B1); PG8_BAR; PG8_SCHED;
            PG8_LDB(B0, 1, 0); PG8_LDB(B1, 1, 1); PG8_SCHED; PG8_LDA(At, 1, 0); PG8_STAGE(PG8_SA(0, 1), a2 + hstep, voffA);
            PG8_WAIT_V(8); PG8_WAIT_L(0); PG8_BAR; PG8_MMA(0, 0, At, B0); PG8_MMA(0, 1, At, B1); PG8_BAR; PG8_SCHED;
            PG8_LDA(At, 1, 1); PG8_STAGE(PG8_SB(1, 0), b3, voffB); PG8_STAGE(PG8_SB(1, 1), b3 + hstep, voffB); PG8_STAGE(PG8_SA(1, 0), a3, voffA);
            PG8_WAIT_V(8); PG8_WAIT_L(0); PG8_BAR; PG8_MMA(1, 0, At, B0); PG8_MMA(1, 1, At, B1); PG8_BAR; PG8_SCHED;
            } else {
            PG8_LDB(B0, 0, 0); PG8_SCHED; PG8_LDA(At, 0, 0); PG8_STAGE(PG8_SA(1, 1), a1 + hstep, voffA);
            PG8_WAIT_L(8); PG8_BAR; PG8_WAIT_L(0); PG8_MMA(0, 0, At, B0); PG8_BAR; PG8_SCHED;
            PG8_LDB(B1, 0, 1); PG8_STAGE(PG8_SB(0, 0), b2, voffB);
            PG8_BAR; PG8_WAIT_L(0); PG8_MMA(0, 1, At, B1); PG8_BAR;
            PG8_LDA(At, 0, 1); PG8_STAGE(PG8_SA(0, 0), a2, voffA);
            PG8_BAR; PG8_WAIT_L(0); PG8_MMA(1, 0, At, B0); PG8_BAR; PG8_SCHED;
            PG8_STAGE(PG8_SB(0, 1), b2 + hstep, voffB);
            PG8_WAIT_V(6); PG8_BAR; PG8_MMA(1, 1, At, B1); PG8_BAR;
            PG8_LDB(B0, 1, 0); PG8_SCHED; PG8_LDA(At, 1, 0); PG8_STAGE(PG8_SA(0, 1), a2 + hstep, voffA);
            PG8_WAIT_L(8); PG8_BAR; PG8_WAIT_L(0); PG8_MMA(0, 0, At, B0); PG8_BAR; PG8_SCHED;
            PG8_LDB(B1, 1, 1); PG8_STAGE(PG8_SB(1, 0), b3, voffB);
            PG8_BAR; PG8_WAIT_L(0); PG8_MMA(0, 1, At, B1); PG8_BAR;
            PG8_LDA(At, 1, 1); PG8_STAGE(PG8_SA(1, 0), a3, voffA);
            PG8_BAR; PG8_WAIT_L(0); PG8_MMA(1, 0, At, B0); PG8_BAR; PG8_SCHED;
            PG8_STAGE(PG8_SB(1, 1), b3 + hstep, voffB);
            PG8_WAIT_V(6); PG8_BAR; PG8_MMA(1, 1, At, B1); PG8_BAR;
            }
        }
        if constexpr (ALIGN_EPI) { if (wr == 0) PG8_BAR; }
        if constexpr (!Epi::AFTER_DRAIN) { E(acc, cur, wr, wc, fr, fq); S.done(cur); }
        if (!has_next) break;
#pragma unroll
        for (int a = 0; a < 2; ++a)
#pragma unroll
            for (int b = 0; b < 2; ++b)
#pragma unroll
                for (int m = 0; m < 4; ++m)
#pragma unroll
                    for (int n = 0; n < 2; ++n) acc[a][b][m][n] = (f32x4){0.f, 0.f, 0.f, 0.f};
        cur = nxt; cA = nA; cB = nB; ++ui;
        if constexpr (ALIGN_EPI) { if (wr == 1) PG8_BAR; }
    }
    PG8_WAIT_V(0);
    if constexpr (!ALIGN_EPI) { if (wr == 0) PG8_BAR; }
    PG8_BAR;
    if constexpr (Epi::AFTER_DRAIN) { E.fused(acc, cur, wr, wc, fr, fq, lds, wid, lane); S.done(cur); }
#undef PG8_SA
#undef PG8_SB
#undef PG8_STAGE
#undef PG8_LDA
#undef PG8_LDB
#undef PG8_MMA
#undef PG8_WAIT_V
#undef PG8_WAIT_L
#undef PG8_BAR
#undef PG8_SCHED
}
}
constexpr int S = 8192, DM = 2048, NP = 10240, NFF = 5632, NFF2 = 11264;
constexpr int COL_AQ = 0, COL_AK = 1536, COL_AV = 3072, COL_BQ = 4608, COL_BK = 5120, COL_BV = 5632, COL_CQ = 6144, COL_CK = 6656, COL_CV = 7168,
              COL_CQI = 7680, COL_DQ = 8704, COL_DKC = 9216, COL_DVC = 9344, COL_DKS = 9472, COL_DVS = 9600, COL_DKW = 9728, COL_DVW = 9856, COL_MISC = 9984;
constexpr int MI_CKI = 0, MI_BFL = 64, MI_CWI = 68, MI_DG = 84;

namespace pg8 {
struct EpiProj {
    static constexpr bool PERM = true, AFTER_DRAIN = false;
    bf16_t* P; const float* TAB; const float* TABI;
    __device__ __forceinline__ void operator()(const f32x4 (&acc)[2][2][4][2], const Unit& u, int wr, int wc, int fr, int fq) const {
        const int row0 = u.pm * BM + wr * 64 + fr; const int col0 = u.pn * BM + wc * 32 + 8 * fq; const int pn = u.pn;
        int mode0, mode1;
        if (pn < 12 || (pn >= 24 && pn < 28) || pn == 34 || pn == 35) { mode0 = 1; mode1 = 1; }
        else if (pn >= 30 && pn < 34) { mode0 = 2; mode1 = 2; }
        else if (pn >= 36 && pn < 39) { mode0 = 1; mode1 = 0; }
        else if (pn == 39) { mode0 = wc < 2 ? 2 : 0; mode1 = 0; }
        else { mode0 = 0; mode1 = 0; }
#pragma unroll
        for (int ai = 0; ai < 2; ++ai)
#pragma unroll
            for (int m = 0; m < 4; ++m) { const int row = row0 + ai * HALF + m * 16; bf16_t* rowp = P + (size_t)row * NP + col0;
#pragma unroll
                for (int bj = 0; bj < 2; ++bj) { f32x4 v0 = acc[ai][bj][m][0], v1 = acc[ai][bj][m][1]; const int mode = bj ? mode1 : mode0;
                    if (mode != 0) {
                        const float* tp = mode == 1 ? TAB + ((size_t)row * 64 + 4 * (4 * wc + fq)) * 2 : TABI + ((size_t)row * 32 + 4 * (4 * (wc & 1) + fq)) * 2;
                        const f32x4 t0 = *(const f32x4*)tp, t1 = *(const f32x4*)(tp + 4);
                        f32x4 r0, r1;
                        r0[0] = v0[0] * t0[0] - v0[1] * t0[1]; r0[1] = v0[1] * t0[0] + v0[0] * t0[1]; r0[2] = v0[2] * t0[2] - v0[3] * t0[3]; r0[3] = v0[3] * t0[2] + v0[2] * t0[3];
                        r1[0] = v1[0] * t1[0] - v1[1] * t1[1]; r1[1] = v1[1] * t1[0] + v1[0] * t1[1]; r1[2] = v1[2] * t1[2] - v1[3] * t1[3]; r1[3] = v1[3] * t1[2] + v1[2] * t1[3];
                        v0 = r0; v1 = r1; }
                    u32x4 w; w.x = cvt_pk_bf16(v0[0], v0[1]); w.y = cvt_pk_bf16(v0[2], v0[3]); w.z = cvt_pk_bf16(v1[0], v1[1]); w.w = cvt_pk_bf16(v1[2], v1[3]);
                    *(u32x4*)(rowp + bj * HALF) = w; } }
    }
};
template <int ACT  > struct EpiPlain {
    static constexpr bool PERM = true, AFTER_DRAIN = false;
    bf16_t* O; int ldc; int ncolt; int maxcol;
    __device__ __forceinline__ void operator()(const f32x4 (&acc)[2][2][4][2], const Unit& u, int wr, int wc, int fr, int fq) const {
        const int row0 = u.pm * BM + wr * 64 + fr; const int col0 = (u.pn % ncolt) * BM + wc * 32 + 8 * fq;
#pragma unroll
        for (int ai = 0; ai < 2; ++ai)
#pragma unroll
            for (int m = 0; m < 4; ++m) { bf16_t* rowp = O + (size_t)(row0 + ai * HALF + m * 16) * ldc + col0;
#pragma unroll
                for (int bj = 0; bj < 2; ++bj) { if (col0 + bj * HALF >= maxcol) continue;
                    f32x4 v0 = acc[ai][bj][m][0], v1 = acc[ai][bj][m][1];
                    if (ACT == 1) {
#pragma unroll
                        for (int i = 0; i < 4; ++i) { { const float x = v0[i]; const float t = 0.7978845608028654f * (x + 0.044715f * x * x * x); const float e = __expf(2.f * t); const float th = 1.f - 2.f / (e + 1.f); v0[i] = 0.5f * x * (1.f + th); }
                                                      { const float x = v1[i]; const float t = 0.7978845608028654f * (x + 0.044715f * x * x * x); const float e = __expf(2.f * t); const float th = 1.f - 2.f / (e + 1.f); v1[i] = 0.5f * x * (1.f + th); } } }
                    u32x4 w; w.x = cvt_pk_bf16(v0[0], v0[1]); w.y = cvt_pk_bf16(v0[2], v0[3]); w.z = cvt_pk_bf16(v1[0], v1[1]); w.w = cvt_pk_bf16(v1[2], v1[3]);
                    *(u32x4*)(rowp + bj * HALF) = w; } }
    }
};
struct EpiGate {
    static constexpr bool PERM = true, AFTER_DRAIN = false;
    const bf16_t* Y; const float* bg; bf16_t* MG;
    __device__ __forceinline__ void operator()(const f32x4 (&acc)[2][2][4][2], const Unit& u, int wr, int wc, int fr, int fq) const {
        const int row0 = u.pm * BM + wr * 64 + fr; const int e0 = u.pn * 64 + wc * 16 + fq * 4;
        f32x4 bv[4];
#pragma unroll
        for (int br = 0; br < 4; ++br) bv[br] = *(const f32x4*)(bg + br * DM + e0);
#pragma unroll
        for (int ai = 0; ai < 2; ++ai)
#pragma unroll
            for (int m = 0; m < 4; ++m) { const size_t ro = (size_t)(row0 + ai * HALF + m * 16) * DM + e0; f32x4 sum = {0.f, 0.f, 0.f, 0.f};
#pragma unroll
                for (int br = 0; br < 4; ++br) { const f32x4 a = acc[ai][br >> 1][m][br & 1] + bv[br];
                    const unsigned long long yv = *(const unsigned long long*)(Y + (size_t)br * S * DM + ro);
                    const unsigned ylo = (unsigned)yv, yhi = (unsigned)(yv >> 32);
                    f32x4 y; y[0] = __uint_as_float(ylo << 16); y[1] = __uint_as_float(ylo & 0xffff0000u); y[2] = __uint_as_float(yhi << 16); y[3] = __uint_as_float(yhi & 0xffff0000u);
#pragma unroll
                    for (int i = 0; i < 4; ++i) { const float g = 1.f / (1.f + __expf(-a[i])); sum[i] += g * y[i]; } }
                const unsigned long long o = (unsigned long long)cvt_pk_bf16(sum[0], sum[1]) | ((unsigned long long)cvt_pk_bf16(sum[2], sum[3]) << 32);
                *(unsigned long long*)(MG + ro) = o; }
    }
};
struct EpiRes {
    static constexpr bool PERM = false, AFTER_DRAIN = false;
    const float* base; float* out;
    __device__ __forceinline__ void operator()(const f32x4 (&acc)[2][2][4][2], const Unit& u, int wr, int wc, int fr, int fq) const {
        const int row0 = u.pm * BM + wr * 64 + fr; const int col0 = u.pn * BM + wc * 32 + 4 * fq;
#pragma unroll
        for (int ai = 0; ai < 2; ++ai)
#pragma unroll
            for (int m = 0; m < 4; ++m) { const size_t off = (size_t)(row0 + ai * HALF + m * 16) * DM + col0;
#pragma unroll
                for (int bj = 0; bj < 2; ++bj)
#pragma unroll
                    for (int n = 0; n < 2; ++n) { const f32x4 b = *(const f32x4*)(base + off + bj * HALF + n * 16); *(f32x4*)(out + off + bj * HALF + n * 16) = b + acc[ai][bj][m][n]; } }
    }
};
struct EpiSwiglu {
    static constexpr bool PERM = true, AFTER_DRAIN = false;
    bf16_t* ACT;
    __device__ __forceinline__ void operator()(const f32x4 (&acc)[2][2][4][2], const Unit& u, int wr, int wc, int fr, int fq) const {
        const int row0 = u.pm * BM + wr * 64 + fr; const int col0 = u.pn * HALF + wc * 32 + 8 * fq;
#pragma unroll
        for (int ai = 0; ai < 2; ++ai)
#pragma unroll
            for (int m = 0; m < 4; ++m) { f32x4 r0, r1;
#pragma unroll
                for (int i = 0; i < 4; ++i) { const float g0 = acc[ai][0][m][0][i], g1 = acc[ai][0][m][1][i];
                    r0[i] = g0 / (1.f + __expf(-g0)) * acc[ai][1][m][0][i]; r1[i] = g1 / (1.f + __expf(-g1)) * acc[ai][1][m][1][i]; }
                u32x4 w; w.x = cvt_pk_bf16(r0[0], r0[1]); w.y = cvt_pk_bf16(r0[2], r0[3]); w.z = cvt_pk_bf16(r1[0], r1[1]); w.w = cvt_pk_bf16(r1[2], r1[3]);
                *(u32x4*)(ACT + (size_t)(row0 + ai * HALF + m * 16) * NFF + col0) = w; }
    }
};
struct StackOrder {
    int nMb, nNb, nb, G, c;
    __device__ __forceinline__ void init(int nMb_, int nNb_, int nb_, int G_, int c_) { nMb = nMb_; nNb = nNb_; nb = nb_; G = G_; c = c_; }
    __device__ __forceinline__ bool next(int i, Unit& u) const {
        const long L = (long)i * G + c; const int per = nMb * nNb; if (L >= (long)per * nb) return false;
        const int b = (int)L / per, w = (int)L % per; u.pm = b * nMb + (w % nMb); u.pn = b * nNb + (w / nMb); return true;
    }
    __device__ __forceinline__ void a_ready(const Unit&) const {}
    __device__ __forceinline__ void done(const Unit&) const {}
};
}
#define GAS __attribute__((address_space(1)))
#define LAS __attribute__((address_space(3)))
typedef unsigned short bf16;
typedef unsigned v4u __attribute__((ext_vector_type(4)));
typedef unsigned v2u __attribute__((ext_vector_type(2)));
typedef float f32x4 __attribute__((ext_vector_type(4)));
typedef float f32x16 __attribute__((ext_vector_type(16)));
typedef short bf16x8 __attribute__((ext_vector_type(8)));
typedef short s16x4 __attribute__((ext_vector_type(4)));
typedef GAS unsigned gu32;
#define RLX_AGENT __ATOMIC_RELAXED, __HIP_MEMORY_SCOPE_AGENT
#define LDS_WAIT() asm volatile("s_waitcnt lgkmcnt(0)" ::: "memory")
#define VM_WAIT() asm volatile("s_waitcnt vmcnt(0)" ::: "memory")
__device__ __forceinline__ unsigned f2bf(float f) { unsigned u = __builtin_bit_cast(unsigned, f); return (u + 0x7fffu + ((u >> 16) & 1u)) >> 16; }
__device__ __forceinline__ unsigned pk2(float lo, float hi) { return f2bf(lo) | (f2bf(hi) << 16); }
__device__ __forceinline__ float bf2f(unsigned short b) { return __uint_as_float((unsigned)b << 16); }
__device__ __forceinline__ float bflo(unsigned w) { return __uint_as_float(w << 16); }
__device__ __forceinline__ float bfhi(unsigned w) { return __uint_as_float(w & 0xffff0000u); }
__device__ __forceinline__ unsigned cvtpk(float lo, float hi) { unsigned r; asm volatile("v_cvt_pk_bf16_f32 %0, %1, %2" : "=v"(r) : "v"(lo), "v"(hi)); return r; }
__device__ __forceinline__ float wave_sum(float v) {
#pragma unroll
    for (int o = 1; o < 64; o <<= 1) v += __shfl_xor(v, o);
    return v;
}
#define XB_TMO      128
#define XB_XCNT(j)  (256  + 64 * (j))
#define XB_XSUB(j)  (1280 + 64 * (j))
#define XB_XGEN(j)  (2304 + 64 * (j))
#define XB_TOP      3328
#define XB_TOPGEN   3392
#define XCD_BAR_WORDS 3456
#define XB_SPIN_CAP (1u << 18)

__device__ __forceinline__ unsigned xb_ld(unsigned* p)              { return __hip_atomic_load(p, __ATOMIC_RELAXED, __HIP_MEMORY_SCOPE_AGENT); }
__device__ __forceinline__ unsigned xb_add(unsigned* p, unsigned v) { return __hip_atomic_fetch_add(p, v, __ATOMIC_RELAXED, __HIP_MEMORY_SCOPE_AGENT); }
__device__ __forceinline__ unsigned xb_xcc_id() { return (unsigned)__builtin_amdgcn_s_getreg((3 << 11) | 20) & 0xFu; }
#define XB_SPIN(cond, bar) do { unsigned _sp = 0; while (cond) { __builtin_amdgcn_s_sleep(1); \
    if ((++_sp & 255u) == 0u) { if (xb_ld(&(bar)[XB_TMO])) break; if (_sp > XB_SPIN_CAP) { atomicAdd(&(bar)[XB_TMO], 1u); break; } } } } while (0)

struct XcdBarrier {
    unsigned* bar; unsigned x;
    volatile LAS unsigned* st;
};

__device__ __forceinline__ XcdBarrier xcd_barrier_post(unsigned* bar, volatile LAS unsigned* st) {
    XcdBarrier b; b.bar = bar; b.x = xb_xcc_id(); b.st = st;
    if (threadIdx.x == 0) (void)xb_add(&bar[XB_XCNT(b.x)], 1u);
    return b;
}
__device__ __forceinline__ void xcd_barrier_complete(unsigned* bar, unsigned x, unsigned& nloc, unsigned& nx) {
    const unsigned G = gridDim.x * gridDim.y * gridDim.z;
    unsigned sum, cnt, mine, sp = 0u;
    for (;;) {
        sum = 0u; cnt = 0u; mine = 0u;
#pragma unroll
        for (unsigned j = 0; j < 16; ++j) { const unsigned c = xb_ld(&bar[XB_XCNT(j)]); sum += c; cnt += (c > 0u) ? 1u : 0u; mine = (j == x) ? c : mine; }
        if (sum == G) break;
        __builtin_amdgcn_s_sleep(1);
        if ((++sp & 255u) == 0u) { if (xb_ld(&bar[XB_TMO])) break; if (sp > XB_SPIN_CAP) { atomicAdd(&bar[XB_TMO], 1u); break; } }
    }
    nloc = mine > 0u ? mine : 1u; nx = cnt > 0u ? cnt : 1u;
}

__device__ __forceinline__ void xcd_barrier(const XcdBarrier& b) {
    asm volatile("s_waitcnt vmcnt(0)" ::: "memory");
    __syncthreads();
    if (threadIdx.x == 0) {
        unsigned* bar = b.bar;
        __builtin_amdgcn_s_waitcnt(0);
        unsigned nloc = b.st[0], nx = b.st[1];
        if (nloc == 0u) { xcd_barrier_complete(bar, b.x, nloc, nx); b.st[0] = nloc; b.st[1] = nx; }
        const unsigned old = xb_add(&bar[XB_XSUB(b.x)], 1u);
        const unsigned gen = old / nloc;
        if (old + 1u == (gen + 1u) * nloc) {
            __builtin_amdgcn_fence(__ATOMIC_RELEASE, "agent");
            asm volatile("s_waitcnt vmcnt(0)" ::: "memory");
            const unsigned og = xb_add(&bar[XB_TOP], 1u);
            const unsigned tg = og / nx;
            if (og + 1u == (tg + 1u) * nx) xb_add(&bar[XB_TOPGEN], 1u);
            else XB_SPIN(xb_ld(&bar[XB_TOPGEN]) == tg, bar);
            __builtin_amdgcn_fence(__ATOMIC_ACQUIRE, "agent");
            xb_add(&bar[XB_XGEN(b.x)], 1u);
            asm volatile("s_waitcnt vmcnt(0)" ::: "memory");
        } else {
            XB_SPIN(xb_ld(&bar[XB_XGEN(b.x)]) == gen, bar);
            __builtin_amdgcn_fence(__ATOMIC_ACQUIRE, "agent");
            asm volatile("s_waitcnt vmcnt(0)" ::: "memory");
        }
    }
    __syncthreads();
}
namespace att {
constexpr float SCALE = 0.08838834764831845f, LOG2E = 1.4426950408889634f, LN2 = 0.6931471805599453f;
#define KSWZ(row, colB) ((row) * 256 + ((colB) ^ (((row) & 7) << 4)))
#define MFMA32(a, b, c) __builtin_amdgcn_mfma_f32_32x32x16_bf16((a), (b), (c), 0, 0, 0)
__device__ __forceinline__ int crow(int r, int hi) { return (r & 3) + 8 * (r >> 2) + 4 * hi; }
__device__ __forceinline__ int v_st(int k, int c) { const int kk = (k & ~0xC) | ((k & 4) << 1) | ((k & 8) >> 1); return ((kk >> 3) * 4 + (c >> 5)) * 512 + ((kk & 7) * 32 + (c & 31)) * 2; }
__device__ __forceinline__ int v_rd_base(int lane) { return ((lane & 3) << 3) | (((lane >> 2) & 3) << 6) | (((lane >> 4) & 1) << 5) | (((lane >> 5) & 1) << 8); }
__device__ __forceinline__ constexpr int v_rd_off(int d0, int ks, int half) { return d0 * 512 + ks * 4096 + half * 2048; }
typedef short v4i16_t __attribute__((ext_vector_type(4)));
__device__ __forceinline__ s16x4 tr_read(const LAS char* p) { return __builtin_bit_cast(s16x4, __builtin_amdgcn_ds_read_tr16_b64_v4i16((LAS v4i16_t*)p)); }
__device__ __forceinline__ float swap_max(float x) { auto rr = __builtin_amdgcn_permlane32_swap(__float_as_uint(x), __float_as_uint(x), false, false); return fmaxf(__uint_as_float(rr[0]), __uint_as_float(rr[1])); }
__device__ __forceinline__ float swap_add(float x) { auto rr = __builtin_amdgcn_permlane32_swap(__float_as_uint(x), __float_as_uint(x), false, false); return __uint_as_float(rr[0]) + __uint_as_float(rr[1]); }

enum { M_A = 0, M_B = 1, M_C = 2, M_SLC = 3, M_WIN = 4, M_CMP = 5 };
constexpr int ATT_LDS_V = 0, ATT_LDS_K = 16384, ATT_LDS_WS = 32768, ATT_LDS_CB = 32768 + 2048, ATT_LDS_END = 32768 + 2048 + 256;

struct AttnP {
    const bf16* Q; const bf16* K; const bf16* V; bf16* O; float* LSE;
    const float* cum;
    const unsigned* bm;
    int q_pitch, kv_pitch, o_pitch, lse_pitch;
    int q_tok0, q_tstride, q_sub0;
    int k_tok0, k_tstride;
    int j_lo, j_hi;
};

template <int MODE, bool GQA>
__device__ __forceinline__ void attn_unit(const AttnP& p, LAS char* lds) {
    int tid_ = threadIdx.x; asm volatile("" : "+v"(tid_));
    const int tid = tid_, lane = tid & 63, r32 = lane & 31, hi = lane >> 5;
    const int wid = __builtin_amdgcn_readfirstlane(tid >> 6);
    LAS char* V_lds = lds + ATT_LDS_V; LAS char* K_lds = lds + ATT_LDS_K;
    LAS float* wsc = (LAS float*)(lds + ATT_LDS_WS) + wid * 64;
    LAS float* cb = (LAS float*)(lds + ATT_LDS_CB);
    const int rho = GQA ? ((wid >> 2) * 32 + r32) : (wid * 32 + r32);
    const int hcol = GQA ? (wid & 3) * 128 : 0;
    const int qtok = p.q_tok0 + rho * p.q_tstride;
    const int qsub = p.q_sub0 + rho;
    bf16x8 qr[8];
    { const bf16* Qw = p.Q + (size_t)qtok * p.q_pitch + hcol + hi * 8;
#pragma unroll
      for (int d0 = 0; d0 < 8; ++d0) qr[d0] = *(const bf16x8*)(Qw + d0 * 16); }
    float m_reg = -1e30f, l_reg = 0.f; f32x16 o[4];
#pragma unroll
    for (int d = 0; d < 4; ++d)
#pragma unroll
        for (int r = 0; r < 16; ++r) o[d][r] = 0.f;
    const int sr = tid >> 4, sc = (tid & 15) * 8;
    const int vst0 = v_st(sr, sc), vst1 = v_st(32 + sr, sc), kst0 = KSWZ(sr, sc * 2), kst1 = KSWZ(32 + sr, sc * 2);
    const LAS char* vb0 = V_lds + v_rd_base(lane);
    bf16x8 vs0, vs1, ks0, ks1; float cpre = 0.f; unsigned long long bmw = 0ull, bmw_n = 0ull;
    unsigned sel0 = 0u, sel1 = 0u, sel2 = 0u, sel3 = 0u; float cref = 0.f;
    if (MODE == M_SLC) { const v4u s4 = *(const v4u*)(p.bm + (size_t)qtok * 4); sel0 = s4.x; sel1 = s4.y; sel2 = s4.z; sel3 = s4.w; }
    if (MODE == M_B) cref = p.cum[p.q_tok0];
#define ATT_LOADT(j) do { const int kk0_ = 64 * (j) + sr; const size_t t0_ = (size_t)(p.k_tok0 + kk0_ * p.k_tstride) * p.kv_pitch + sc, t1_ = (size_t)(p.k_tok0 + (kk0_ + 32) * p.k_tstride) * p.kv_pitch + sc; \
        ks0 = *(const bf16x8*)(p.K + t0_); ks1 = *(const bf16x8*)(p.K + t1_); vs0 = *(const bf16x8*)(p.V + t0_); vs1 = *(const bf16x8*)(p.V + t1_); \
        if (MODE == M_B) { if (tid < 64) cpre = cref - p.cum[64 * (j) + tid]; } \
        if (MODE == M_C) bmw_n = *(const unsigned long long*)(p.bm + (size_t)qtok * 256 + 2 * (j)); } while (0)
    if (p.j_lo < p.j_hi) {
        ATT_LOADT(p.j_lo);
        for (int j = p.j_lo; j < p.j_hi; ++j) {
            __syncthreads();
            *(LAS bf16x8*)(V_lds + vst0) = vs0; *(LAS bf16x8*)(V_lds + vst1) = vs1; *(LAS bf16x8*)(K_lds + kst0) = ks0; *(LAS bf16x8*)(K_lds + kst1) = ks1;
            if (MODE == M_B) { if (tid < 64) cb[tid] = cpre; }
            if (MODE == M_C) bmw = bmw_n;
            if (j + 1 < p.j_hi) ATT_LOADT(j + 1);
            __syncthreads();
            f32x16 p0, p1;
#pragma unroll
            for (int r = 0; r < 16; ++r) { p0[r] = 0.f; p1[r] = 0.f; }
#pragma unroll
            for (int d0 = 0; d0 < 8; ++d0) { const int cbt = (d0 * 16 + hi * 8) * 2;
                const bf16x8 b0 = *(const LAS bf16x8*)(K_lds + KSWZ(r32, cbt)); const bf16x8 b1 = *(const LAS bf16x8*)(K_lds + KSWZ(32 + r32, cbt));
                p0 = MFMA32(b0, qr[d0], p0); p1 = MFMA32(b1, qr[d0], p1); }
            {
                const float NINF = -__builtin_inff();
                int dq = qsub - 64 * j - 4 * hi;
                asm volatile("" : "+v"(dq));
                int lim = 0; unsigned w0 = 0u, w1 = 0u; bool selb = true;
                if (MODE == M_CMP) { lim = ((qsub - 31) >> 4) - 64 * j - 4 * hi; asm volatile("" : "+v"(lim)); }
                if (MODE == M_C) { w0 = (unsigned)bmw >> (4 * hi); w1 = (unsigned)(bmw >> 32) >> (4 * hi); }
                if (MODE == M_SLC) { const unsigned sw = j < 32 ? sel0 : (j < 64 ? sel1 : (j < 96 ? sel2 : sel3)); selb = ((sw >> (j & 31)) & 1u) != 0u; }
#pragma unroll
                for (int g = 0; g < 4; ++g) {
                    f32x4 bia0 = {0.f, 0.f, 0.f, 0.f}, bia1 = {0.f, 0.f, 0.f, 0.f};
                    if (MODE == M_B) { bia0 = *(const LAS f32x4*)(cb + 8 * g + 4 * hi); bia1 = *(const LAS f32x4*)(cb + 32 + 8 * g + 4 * hi); }
#pragma unroll
                    for (int i = 0; i < 4; ++i) { const int r = 4 * g + i, base = i + 8 * g;
                        bool v0, v1;
                        if (MODE == M_A)        { v0 = (unsigned)(dq - base) <= 128u; v1 = (unsigned)(dq - base - 32) <= 128u; }
                        else if (MODE == M_B)   { v0 = base <= dq; v1 = base + 32 <= dq; }
                        else if (MODE == M_C)   { v0 = ((w0 >> base) & 1u) != 0u; v1 = ((w1 >> base) & 1u) != 0u; }
                        else if (MODE == M_SLC) { v0 = selb && base <= dq; v1 = selb && base + 32 <= dq; }
                        else if (MODE == M_WIN) { v0 = (unsigned)(dq - base) < 512u; v1 = (unsigned)(dq - base - 32) < 512u; }
                        else                    { v0 = base <= lim; v1 = base + 32 <= lim; }
                        p0[r] = v0 ? fmaf(p0[r], SCALE, bia0[i]) : NINF; p1[r] = v1 ? fmaf(p1[r], SCALE, bia1[i]) : NINF; }
                }
            }
            float pmax = p0[0];
#pragma unroll
            for (int r = 1; r < 16; ++r) pmax = fmaxf(pmax, p0[r]);
#pragma unroll
            for (int r = 0; r < 16; ++r) pmax = fmaxf(pmax, p1[r]);
            pmax = swap_max(pmax);
            const float mn = fmaxf(m_reg, pmax); const float alpha = __builtin_amdgcn_exp2f((m_reg - mn) * LOG2E); m_reg = mn;
            const float mnC = -mn * LOG2E;
#pragma unroll
            for (int r = 0; r < 16; ++r) { p0[r] = __builtin_amdgcn_exp2f(fmaf(p0[r], LOG2E, mnC)); p1[r] = __builtin_amdgcn_exp2f(fmaf(p1[r], LOG2E, mnC)); }
            float ps = 0.f;
#pragma unroll
            for (int r = 0; r < 16; ++r) ps += p0[r] + p1[r];
            ps = swap_add(ps);
            l_reg = l_reg * alpha + ps;
            if (__any(alpha < 1.f)) {
                if (hi == 0) wsc[r32] = alpha;
                LDS_WAIT();
#pragma unroll
                for (int r = 0; r < 16; ++r) { const float a = wsc[crow(r, hi)];
#pragma unroll
                    for (int d = 0; d < 4; ++d) o[d][r] *= a; }
            }
            bf16x8 pa0, pa1, pa2, pa3;
#define ATT_PK4(P, BASE, OUT) do { unsigned a0 = cvtpk(P[BASE + 0], P[BASE + 1]), a1 = cvtpk(P[BASE + 2], P[BASE + 3]); \
                unsigned b0_ = cvtpk(P[BASE + 4], P[BASE + 5]), b1_ = cvtpk(P[BASE + 6], P[BASE + 7]); \
                auto r0 = __builtin_amdgcn_permlane32_swap(a0, b0_, false, false); auto r1 = __builtin_amdgcn_permlane32_swap(a1, b1_, false, false); \
                v4u w = {r0[0], r1[0], r0[1], r1[1]}; OUT = __builtin_bit_cast(bf16x8, w); } while (0)
            ATT_PK4(p0, 0, pa0); ATT_PK4(p0, 8, pa1); ATT_PK4(p1, 0, pa2); ATT_PK4(p1, 8, pa3);
#define ATT_PKV(L, H) (bf16x8){L[0], L[1], L[2], L[3], H[0], H[1], H[2], H[3]}
#pragma unroll
            for (int d0 = 0; d0 < 4; ++d0) {
                const s16x4 l0 = tr_read(vb0 + v_rd_off(d0, 0, 0)), h0 = tr_read(vb0 + v_rd_off(d0, 0, 1)), l1 = tr_read(vb0 + v_rd_off(d0, 1, 0)), h1 = tr_read(vb0 + v_rd_off(d0, 1, 1));
                const s16x4 l2 = tr_read(vb0 + v_rd_off(d0, 2, 0)), h2 = tr_read(vb0 + v_rd_off(d0, 2, 1)), l3 = tr_read(vb0 + v_rd_off(d0, 3, 0)), h3 = tr_read(vb0 + v_rd_off(d0, 3, 1));
                o[d0] = MFMA32(pa0, ATT_PKV(l0, h0), o[d0]); o[d0] = MFMA32(pa1, ATT_PKV(l1, h1), o[d0]);
                o[d0] = MFMA32(pa2, ATT_PKV(l2, h2), o[d0]); o[d0] = MFMA32(pa3, ATT_PKV(l3, h3), o[d0]);
            }
        }
    }
#undef ATT_LOADT
    if (hi == 0) wsc[32 + r32] = l_reg;
    if (p.LSE != nullptr && hi == 0) p.LSE[(size_t)qtok * p.lse_pitch + (GQA ? (wid & 3) : 0)] = l_reg > 0.f ? m_reg + __builtin_amdgcn_logf(l_reg) * LN2 : -1e30f;
    LDS_WAIT();
    const int rowbase = GQA ? (wid >> 2) * 32 : wid * 32;
#pragma unroll
    for (int r = 0; r < 16; ++r) { const int rr = crow(r, hi); const float lv = wsc[32 + rr]; const float rl = lv > 0.f ? 1.f / lv : 0.f;
        bf16* orow = p.O + (size_t)(p.q_tok0 + (rowbase + rr) * p.q_tstride) * p.o_pitch + hcol + r32;
#pragma unroll
        for (int d0 = 0; d0 < 4; ++d0) orow[d0 * 32] = (bf16)f2bf(o[d0][r] * rl); }
}

__device__ __forceinline__ void idx_unit(const bf16* P, float* SC, int qb, int kc, LAS char* lds) {
    int tid_ = threadIdx.x; asm volatile("" : "+v"(tid_));
    const int tid = tid_, lane = tid & 63, r32 = lane & 31, hi = lane >> 5;
    const int wid = __builtin_amdgcn_readfirstlane(tid >> 6);
    __syncthreads();
#pragma unroll
    for (int i = 0; i < 2; ++i) { const int idx = tid + 512 * i, row = idx >> 3, ch = idx & 7;
        const bf16x8 v = *(const bf16x8*)(P + (size_t)(128 * kc + row) * NP + COL_MISC + MI_CKI + ch * 8);
        *(LAS bf16x8*)(lds + row * 128 + ((ch * 16) ^ ((row & 7) << 4))) = v; }
    __syncthreads();
    const int t = 256 * qb + wid * 32 + r32;
    f32x16 acc[4];
#pragma unroll
    for (int s = 0; s < 4; ++s)
#pragma unroll
        for (int r = 0; r < 16; ++r) acc[s][r] = 0.f;
    const bf16* qrow = P + (size_t)t * NP + COL_CQI + hi * 8;
    const bf16* wrow = P + (size_t)t * NP + COL_MISC + MI_CWI;
    const LAS char* kbase = lds + r32 * 128;
    const int sw = (r32 & 7) << 4;
#pragma unroll 1
    for (int h = 0; h < 16; ++h) {
        bf16x8 qf[4];
#pragma unroll
        for (int ks = 0; ks < 4; ++ks) qf[ks] = *(const bf16x8*)(qrow + h * 64 + ks * 16);
        const float w = bf2f(wrow[h]) * 0.03125f;
#pragma unroll
        for (int s = 0; s < 4; ++s) {
            f32x16 pp;
#pragma unroll
            for (int r = 0; r < 16; ++r) pp[r] = 0.f;
#pragma unroll
            for (int ks = 0; ks < 4; ++ks) { const bf16x8 kf = *(const LAS bf16x8*)(kbase + s * 4096 + (((ks * 2 + hi) * 16) ^ sw)); pp = MFMA32(kf, qf[ks], pp); }
#pragma unroll
            for (int r = 0; r < 16; ++r) acc[s][r] = fmaf(w, fmaxf(pp[r], 0.f), acc[s][r]);
        }
    }
    float* out = SC + (size_t)65536 * (qb * (qb + 1) / 2) + (size_t)(wid * 32 + r32) * (256 * (qb + 1)) + 128 * kc + 4 * hi;
#pragma unroll
    for (int s = 0; s < 4; ++s)
#pragma unroll
        for (int g = 0; g < 4; ++g) { const f32x4 v = {acc[s][4 * g], acc[s][4 * g + 1], acc[s][4 * g + 2], acc[s][4 * g + 3]}; *(f32x4*)(out + 32 * s + 8 * g) = v; }
}

__device__ __forceinline__ int wave_isum(int v) {
#pragma unroll
    for (int o = 1; o < 64; o <<= 1) v += __shfl_xor(v, o);
    return v;
}
#define WRL(dst, sval, ln) asm volatile("s_nop 3\n\tv_writelane_b32 %0, %1, %2\n\ts_nop 1" : "+v"(dst) : "s"(sval), "n"(ln))
template <int NCH>
__device__ __forceinline__ void select_row(const float* SC, unsigned* BM, int t, int lane_) {
    int lane = lane_; asm volatile("" : "+v"(lane));
    const int qb_ = t >> 8; const float* row = SC + (size_t)65536 * (qb_ * (qb_ + 1) / 2) + (size_t)(t & 255) * (256 * (qb_ + 1));
    unsigned key[NCH];
#pragma unroll
    for (int i = 0; i < NCH; ++i) { const int k = i * 64 + lane; unsigned u = 0u;
        if (k <= t) { u = __float_as_uint(row[k]); u = (u & 0x80000000u) ? ~u : (u | 0x80000000u); }
        key[i] = u; }
    unsigned prefix = 1u; int cge = t + 1;
    if (t >= 256) {
        prefix = 0u;
#pragma unroll 1
        for (int bit = 31; bit >= 0; --bit) {
            const unsigned cand = prefix | (1u << bit); int c = 0;
#pragma unroll
            for (int i = 0; i < NCH; ++i) c += (key[i] >= cand) ? 1 : 0;
            c = wave_isum(c);
            if (c >= 256) { prefix = cand; cge = c; }
            if (c == 256) break;
        }
    }
    const int target = t >= 256 ? 256 : t + 1;
    unsigned m0l = 0u, m0h = 0u, m1l = 0u, m1h = 0u;
    if (cge == target) {
#pragma unroll
        for (int i = 0; i < NCH; ++i) { const unsigned long long b = __ballot(key[i] >= prefix);
            if (i < 64) { WRL(m0l, (unsigned)b, i & 63); WRL(m0h, (unsigned)(b >> 32), i & 63); }
            else { WRL(m1l, (unsigned)b, i & 63); WRL(m1h, (unsigned)(b >> 32), i & 63); }
            __builtin_amdgcn_sched_barrier(0); }
    } else {
        int cgt = 0;
#pragma unroll
        for (int i = 0; i < NCH; ++i) cgt += (key[i] > prefix) ? 1 : 0;
        cgt = wave_isum(cgt);
        const int need = target - cgt; int run = 0; const unsigned long long lt = (1ull << lane) - 1ull;
#pragma unroll
        for (int i = 0; i < NCH; ++i) {
            const bool eq = key[i] == prefix; const unsigned long long beq = __ballot(eq);
            const bool selk = key[i] > prefix || (eq && (run + (int)__popcll(beq & lt)) < need);
            run += (int)__popcll(beq);
            const unsigned long long b = __ballot(selk);
            if (i < 64) { WRL(m0l, (unsigned)b, i & 63); WRL(m0h, (unsigned)(b >> 32), i & 63); }
            else { WRL(m1l, (unsigned)b, i & 63); WRL(m1h, (unsigned)(b >> 32), i & 63); }
            __builtin_amdgcn_sched_barrier(0);
        }
    }
    const int nwords = 8 * ((t >> 8) + 1);
    unsigned* brow = BM + (size_t)t * 256;
    if (2 * lane < nwords && lane < NCH) { const v2u o = {m0l, m0h}; *(v2u*)(brow + 2 * lane) = o; }
    if (NCH > 64) { if (128 + 2 * lane < nwords) { const v2u o = {m1l, m1h}; *(v2u*)(brow + 128 + 2 * lane) = o; } }
}
}
constexpr size_t MiB = 1u << 20;
constexpr size_t WS_CTL = 0, CTL_ZERO_BYTES = 1 * MiB;
constexpr size_t WS_TAB = 1 * MiB, WS_TABI = 5 * MiB, WS_OVM = 7 * MiB, WS_KI = 8 * MiB, WS_CUM = 9 * MiB, WS_KVC = 9 * MiB + 512 * 1024, WS_HID = 10 * MiB, WS_SEL = 11 * MiB;
constexpr size_t WS_LSEA = 12 * MiB, WS_LSEB = WS_LSEA + 384 * 1024, WS_LSEC = WS_LSEB + 512 * 1024, WS_LSES = WS_LSEC + 512 * 1024;
constexpr size_t WS_CA = 14 * MiB, WS_BM = 22 * MiB, WS_W2T = 30 * MiB, WS_W1T = 31 * MiB, WS_XN = 40 * MiB, WS_X2 = 72 * MiB;
constexpr size_t WS_RA = 136 * MiB, WS_P = WS_RA, WS_Y = WS_RA, WS_WFI = WS_RA, WS_WFO = WS_RA + 44 * MiB;
constexpr size_t WS_RB = 296 * MiB, WS_OA = WS_RB, WS_PB = WS_OA + 24 * MiB, WS_PC = WS_PB + 32 * MiB, WS_PS = WS_PC + 32 * MiB, WS_OCMP = WS_PS + 32 * MiB, WS_OWIN = WS_OCMP + 8 * MiB, WS_IMPH = WS_OWIN + 8 * MiB;
constexpr size_t WS_MG = WS_RB, WS_ACT = WS_RB + 32 * MiB;
constexpr size_t WS_RC = 440 * MiB, WS_WIN = WS_RC, WS_SC = WS_RC, WS_WG = WS_RC, WS_WB = WS_RC + 32 * MiB, WS_WO = WS_RC + 40 * MiB;
constexpr size_t WS_BR = WS_RC + 64 * MiB, WS_END = 572 * MiB;
static_assert(WS_IMPH + 8 * MiB <= WS_RC && WS_ACT + 88 * MiB <= WS_RC && WS_WFO + 22 * MiB <= WS_RB, "ws map");
constexpr int CW_BAR = 4096;
constexpr int RING_BYTES = 131072, LDSCTL_OFF = RING_BYTES, MISC_OFF = LDSCTL_OFF + 320, LDS_BYTES = 147456;
constexpr int NWAVES = 8;
struct Frame { LAS unsigned char* lds; int tid, lane, wave, G, gw, NGW; };
__device__ __forceinline__ void mkframe(Frame& F, unsigned char* lds_raw) { int t = threadIdx.x; asm volatile("" : "+v"(t)); F.lds = (LAS unsigned char*)lds_raw; F.tid = t; F.lane = t & 63; F.wave = __builtin_amdgcn_readfirstlane(t >> 6);
    F.G = gridDim.x; F.gw = blockIdx.x * NWAVES + F.wave; F.NGW = F.G * NWAVES; }
enum { MAP_ID = 0, MAP_IN = 1, MAP_GATE = 2, MAP_FFI = 3, MAP_W2 = 4, MAP_W2P = 5 };
template <int MAP> __device__ __forceinline__ int src_col(int n) {
    if (MAP == MAP_IN) {
        const int p7 = n & 127, d128 = 4 * (p7 >> 3) + ((p7 >> 1) & 3) + 64 * (p7 & 1), hb = n & ~127;
        const int p6 = n & 63, d64 = 4 * (p6 >> 3) + ((p6 >> 1) & 3) + 32 * (p6 & 1), hb64 = n & ~63;
        if (n < 3072) return hb + d128;
        if (n < 6144) return n;
        if (n < 7168) return hb + 4 + d128;
        if (n < 7680) return n + 4;
        if (n < 8704) return hb64 + 4 + d64;
        if (n < 9216) return hb + 84 + d128;
        if (n < 9984) return (((n - 9216) >> 7) & 1) ? n + 84 : hb + 84 + d128;
        if (n < 10048) return 8708 + d64;
        if (n < 10052) return 6144 + (n - 10048);
        if (n < 10068) return 8772 + (n - 10052);
        if (n < 10080) return n;
        return -1;
    } else if (MAP == MAP_GATE) {
        const int pn = n >> 8, c = n & 255, bj = c >> 7, wc = (c >> 5) & 3, fq = (c >> 3) & 3, nn = (c >> 2) & 1, i = c & 3;
        return (2 * bj + nn) * DM + 64 * pn + 16 * wc + 4 * fq + i;
    } else if (MAP == MAP_FFI) {
        const int pn = n >> 8, c = n & 255; return ((c >> 7) ? NFF : 0) + 128 * pn + (c & 127);
    } else if (MAP == MAP_W2) {
        return n < 128 ? n : -1;
    } else if (MAP == MAP_W2P) {
        return n < 128 ? 4 * (n >> 3) + ((n >> 1) & 3) + 64 * (n & 1) : -1;
    } else return n;
}
template <int MAP> __device__ __forceinline__ void transpose_item(const float* W, int K, int Nsrc, int Ndst, bf16* WT, LAS float* scr, int item, int lane) {
    const int nblk = Ndst / 32, kb = item / nblk, nb = item % nblk, k0 = 64 * kb, n0 = 32 * nb;
    const int sc = src_col<MAP>(n0 + (lane & 31));
#pragma unroll 8
    for (int i = 0; i < 32; ++i) { const int kk = 2 * i + (lane >> 5); scr[kk * 33 + (lane & 31)] = sc >= 0 ? W[(size_t)(k0 + kk) * Nsrc + sc] : 0.f; }
    LDS_WAIT(); asm volatile("" ::: "memory");
    const int c = lane & 7;
#pragma unroll
    for (int j = 0; j < 4; ++j) { const int n = (lane >> 3) + 8 * j; const LAS float* s = scr + (8 * c) * 33 + n;
        v4u o; o.x = pk2(s[0 * 33], s[1 * 33]); o.y = pk2(s[2 * 33], s[3 * 33]); o.z = pk2(s[4 * 33], s[5 * 33]); o.w = pk2(s[6 * 33], s[7 * 33]);
        *(v4u*)(WT + (size_t)(n0 + n) * K + k0 + 8 * c) = o; }
    LDS_WAIT(); asm volatile("" ::: "memory");
}
template <int MAP> __device__ __forceinline__ void transpose_all(const Frame& F, const float* W, int K, int Nsrc, int Ndst, bf16* WT) {
    LAS float* scr = (LAS float*)(F.lds + F.wave * 16384);
    const int nitems = (K / 64) * (Ndst / 32);
    for (int it = F.gw; it < nitems; it += F.NGW) transpose_item<MAP>(W, K, Nsrc, Ndst, WT, scr, it, F.lane);
}
__device__ __forceinline__ void rms_row(const float* xrow, const float* g, bf16* obf, float* of32, int lane) {
    const f32x4* xr = (const f32x4*)xrow + lane; const f32x4* gr = (const f32x4*)g + lane;
    f32x4 v[8]; float s = 0.f;
#pragma unroll
    for (int j = 0; j < 8; ++j) { v[j] = xr[64 * j]; s += (v[j].x * v[j].x + v[j].y * v[j].y) + (v[j].z * v[j].z + v[j].w * v[j].w); }
    const float r = 1.0f / sqrtf(wave_sum(s) * (1.f / DM) + 1e-6f);
#pragma unroll
    for (int j = 0; j < 8; ++j) { const f32x4 gv = gr[64 * j]; const f32x4 y = {v[j].x * r * gv.x, v[j].y * r * gv.y, v[j].z * r * gv.z, v[j].w * r * gv.w};
        if (obf) { v2u o; o.x = pk2(y.x, y.y); o.y = pk2(y.z, y.w); *((v2u*)obf + lane + 64 * j) = o; }
        else *((f32x4*)of32 + lane + 64 * j) = y; }
}
__device__ __forceinline__ float2 cossin_d(float angf) {
    const double x = (double)angf; const double k = rint(x * 0.6366197723675814);
    double r = fma(-k, 1.5707963267948966, x); r = fma(-k, 6.123233995736766e-17, r);
    const int q = (int)k & 3; const double r2 = r * r;
    const double sn = r * (1.0 + r2 * (-1.0 / 6 + r2 * (1.0 / 120 + r2 * (-1.0 / 5040 + r2 * (1.0 / 362880 + r2 * (-1.0 / 39916800 + r2 * (1.0 / 6227020800.0)))))));
    const double cn = 1.0 + r2 * (-0.5 + r2 * (1.0 / 24 + r2 * (-1.0 / 720 + r2 * (1.0 / 40320 + r2 * (-1.0 / 3628800 + r2 * (1.0 / 479001600 + r2 * (-1.0 / 87178291200.0)))))));
    const double c = (q == 0) ? cn : (q == 1) ? -sn : (q == 2) ? -cn : sn;
    const double s_ = (q == 0) ? sn : (q == 1) ? cn : (q == 2) ? -sn : -cn;
    return make_float2((float)c, (float)s_);
}
__device__ __forceinline__ void build_tables(const Frame& F, float2* TAB, float2* TABI, bf16* OVM) {
    const int gt = F.gw * 64 + F.lane, NT = F.NGW * 64;
    for (int i = gt; i < S * 64; i += NT) { const int t = i >> 6, d = i & 63;
        double f = 1.0; for (int k = 0; k < d; ++k) f *= 0.8659643233600653523;
        TAB[i] = cossin_d((float)t * (float)f); }
    for (int i = gt; i < S * 32; i += NT) { const int t = i >> 5, d = i & 31;
        double f = 1.0; for (int k = 0; k < d; ++k) f *= 0.7498942093324558273;
        TABI[i] = cossin_d((float)t * (float)f); }
    for (int i = gt; i < 512 * 128; i += NT) { const int n = i >> 7, j = i & 127; OVM[i] = (n < 511 && n >= 4 * j - 1 && n <= 4 * j + 3) ? (bf16)0x3F80 : (bf16)0; }
}
__device__ __forceinline__ void prep_phase(const Frame& F, const bf16* P, bf16* CA, float* CUM, const float* pe, const float* bf_) {
    const int lane = F.lane;
    const int p1 = 8 * (lane >> 2) + 2 * (lane & 3);
    for (int it = F.gw; it < 1024; it += F.NGW) { const int kv = it >> 9, n = it & 511; bf16* dst = CA + (size_t)it * 4096;
        for (int i = 0; i < 32; ++i) { float y1 = 0.f, y2 = 0.f;
            if (n < 511) { const int t = 16 * n + i; const bf16* b = P + (size_t)t * NP + (kv ? COL_DVC : COL_DKC);
                if (kv == 0) { y1 = bf2f(b[p1]); y2 = bf2f(b[p1 + 1]); } else { y1 = bf2f(b[lane]); y2 = bf2f(b[64 + lane]); }
                y1 += pe[(kv * 32 + i) * 128 + lane]; y2 += pe[(kv * 32 + i) * 128 + 64 + lane]; }
            dst[i * 128 + lane] = (bf16)f2bf(y1); dst[i * 128 + 64 + lane] = (bf16)f2bf(y2); } }
    if (blockIdx.x < 4) { const int h = blockIdx.x; LAS double* wt = (LAS double*)(F.lds + 131072 - 256);
        double loc[16]; double run = 0.0; const float bfh = bf_[h];
#pragma unroll
        for (int k = 0; k < 16; ++k) { const float x = bf2f(P[(size_t)(F.tid * 16 + k) * NP + COL_MISC + MI_BFL + h]) + bfh; run += (double)(fminf(x, 0.f) - log1pf(__expf(-fabsf(x)))); loc[k] = run; }
        double sc = run;
#pragma unroll
        for (int o = 1; o < 64; o <<= 1) { const double u = __shfl_up(sc, o); if (lane >= o) sc += u; }
        if (lane == 63) wt[F.wave] = sc;
        __syncthreads();
        double off = sc - run;
        for (int w = 0; w < F.wave; ++w) off += wt[w];
#pragma unroll
        for (int k = 0; k < 16; ++k) CUM[(size_t)h * S + F.tid * 16 + k] = (float)(off + loc[k]);
        __syncthreads();
    }
}
__device__ __forceinline__ void combine_phase(const Frame& F, const unsigned char* ws, bf16* BR) {
    const int lane = F.lane;
    const bf16* OA = (const bf16*)(ws + WS_OA); const bf16* PB = (const bf16*)(ws + WS_PB); const bf16* PC = (const bf16*)(ws + WS_PC); const bf16* PS = (const bf16*)(ws + WS_PS);
    const bf16* OCMP = (const bf16*)(ws + WS_OCMP); const bf16* OWIN = (const bf16*)(ws + WS_OWIN);
    const float* LA = (const float*)(ws + WS_LSEA); const float* LB = (const float*)(ws + WS_LSEB); const float* LC = (const float*)(ws + WS_LSEC); const float* LS = (const float*)(ws + WS_LSES);
    const bf16* P = (const bf16*)(ws + WS_P);
    for (int t = F.gw; t < S; t += F.NGW) {
        const int nchB = ((t >> 8) + 8) >> 3, nchS = (t >> 11) + 1;
#pragma unroll 1
        for (int h = 0; h < 4; ++h) {
            const size_t eo = (size_t)t * 512 + h * 128 + 2 * lane;
#define COMBINE(PBUF, LBUF, NCH, R0, R1) do { float mx = -1e30f; float lv[4]; \
                _Pragma("unroll") for (int c = 0; c < 4; ++c) { lv[c] = c < (NCH) ? (LBUF)[((size_t)c * S + t) * 4 + h] : -1e30f; mx = fmaxf(mx, lv[c]); } \
                float ws_ = 0.f, a0 = 0.f, a1 = 0.f; \
                _Pragma("unroll") for (int c = 0; c < 4; ++c) { if (c < (NCH)) { const float w = (lv[c] > -1e29f) ? __expf(lv[c] - mx) : 0.f; const unsigned v = *(const unsigned*)((PBUF) + (size_t)c * S * 512 + eo); ws_ += w; a0 += w * bflo(v); a1 += w * bfhi(v); } } \
                const float inv = ws_ > 0.f ? 1.f / ws_ : 0.f; R0 = a0 * inv; R1 = a1 * inv; } while (0)
            float r0, r1;
            COMBINE(OA, LA, 3, r0, r1);
#if defined(ZERO_BR) && ZERO_BR == 0
            r0 = 0.f; r1 = 0.f;
#endif
            *(unsigned*)(BR + eo) = pk2(r0, r1);
            COMBINE(PB, LB, nchB, r0, r1);
#if defined(ZERO_BR) && ZERO_BR == 1
            r0 = 0.f; r1 = 0.f;
#endif
            *(unsigned*)(BR + (size_t)S * 512 + eo) = pk2(r0, r1);
            COMBINE(PC, LC, nchB, r0, r1);
#if defined(ZERO_BR) && ZERO_BR == 2
            r0 = 0.f; r1 = 0.f;
#endif
            *(unsigned*)(BR + (size_t)2 * S * 512 + eo) = pk2(r0, r1);
            COMBINE(PS, LS, nchS, r0, r1);
            const bf16* dg = P + (size_t)t * NP + COL_MISC + MI_DG + 3 * h;
            const float g0 = 1.f / (1.f + __expf(-bf2f(dg[0]))), g1 = 1.f / (1.f + __expf(-bf2f(dg[1]))), g2 = 1.f / (1.f + __expf(-bf2f(dg[2])));
            const unsigned vc = *(const unsigned*)(OCMP + eo), vw = *(const unsigned*)(OWIN + eo);
            float gg0 = g0, gg1 = g1, gg2 = g2;
#if defined(ZERO_BR) && ZERO_BR == 3
            gg0 = 0.f; gg1 = 0.f; gg2 = 0.f;
#elif defined(ZERO_BR) && ZERO_BR == 4
            gg0 = 0.f;
#elif defined(ZERO_BR) && ZERO_BR == 5
            gg1 = 0.f;
#elif defined(ZERO_BR) && ZERO_BR == 6
            gg2 = 0.f;
#endif
            *(unsigned*)(BR + (size_t)3 * S * 512 + eo) = pk2(gg0 * bflo(vc) + gg1 * r0 + gg2 * bflo(vw), gg0 * bfhi(vc) + gg1 * r1 + gg2 * bfhi(vw));
#undef COMBINE
        }
    }
}
__device__ __forceinline__ void cmp_select(const bf16* IMPH, unsigned* SEL, int q0, LAS char* lds, int tid) {
    LAS float* imp = (LAS float*)lds;
    asm volatile("" : "+v"(tid));
    const int lane = tid & 63;
    {
        const int q = tid & 63, cg = tid >> 6; const bf16* row = IMPH + (size_t)(q0 + q) * 512 + cg * 16;
        float acc[16];
#pragma unroll
        for (int e = 0; e < 16; ++e) acc[e] = 0.f;
#pragma unroll
        for (int h = 0; h < 4; ++h)
#pragma unroll
            for (int c = 0; c < 2; ++c) { const v4u v = *(const v4u*)(row + h * 128 + c * 8);
                acc[c * 8 + 0] += bflo(v.x); acc[c * 8 + 1] += bfhi(v.x); acc[c * 8 + 2] += bflo(v.y); acc[c * 8 + 3] += bfhi(v.y);
                acc[c * 8 + 4] += bflo(v.z); acc[c * 8 + 5] += bfhi(v.z); acc[c * 8 + 6] += bflo(v.w); acc[c * 8 + 7] += bfhi(v.w); }
#pragma unroll
        for (int e = 0; e < 16; ++e) imp[(cg * 16 + e) * 64 + q] = acc[e];
    }
    __syncthreads();
    if (tid < 64) {
        const int t = q0 + lane, cur = q0 >> 6;
        unsigned s0 = 0u, s1 = 0u, s2 = 0u, s3 = 0u;
#define SETBIT(j) do { const int j_ = (j); const unsigned b_ = 1u << (j_ & 31); if (j_ < 32) s0 |= b_; else if (j_ < 64) s1 |= b_; else if (j_ < 96) s2 |= b_; else s3 |= b_; } while (0)
        if (cur - 2 <= 13) { for (int j = 0; j <= cur; ++j) SETBIT(j); }
        else {
            SETBIT(0); SETBIT(cur); SETBIT(cur - 1);
            const int jmax = cur - 2;
#pragma unroll 1
            for (int it = 0; it < 13; ++it) { float best = -__builtin_inff(); int bi = 1;
#pragma unroll 1
                for (int j = 1; j <= jmax; ++j) { const float v = imp[j * 64 + lane]; const bool ok = v > best; best = ok ? v : best; bi = ok ? j : bi; }
                imp[bi * 64 + lane] = -__builtin_inff();
                SETBIT(bi); }
        }
#undef SETBIT
        const v4u o = {s0, s1, s2, s3}; *(v4u*)(SEL + (size_t)t * 4) = o;
    }
}
struct Args { const float* in[15]; float* out; unsigned char* ws; int ph_lo, ph_hi; };
constexpr int NPH = 14, PH_FINAL = 2 * NPH, PH_END = PH_FINAL + 1;

__device__ __forceinline__ void decode_bc(int u, int& head, int& qb, int& c) {
    head = u & 3; int v = u >> 2; int G;
    if (v < 32) { G = 3; } else if (v < 56) { G = 2; v -= 32; } else if (v < 72) { G = 1; v -= 56; } else { G = 0; v -= 72; }
    qb = 8 * G + 7 - v / (G + 1); c = v % (G + 1);
}
__device__ __forceinline__ void decode_slc(int u, int& b, int& c) {
    int G;
    if (u < 128) { G = 3; } else if (u < 224) { G = 2; u -= 128; } else if (u < 288) { G = 1; u -= 224; } else { G = 0; u -= 288; }
    b = 32 * G + 31 - u / (G + 1); c = u % (G + 1);
}

__global__ void __launch_bounds__(NWAVES * 64, 2) hyb_fwd(Args args) {
    extern __shared__ __attribute__((aligned(16))) unsigned char lds_raw[];
    {
        LAS unsigned char* l0 = (LAS unsigned char*)lds_raw;
        for (int u = threadIdx.x; u < (LDS_BYTES - LDSCTL_OFF) / 4; u += NWAVES * 64) ((LAS unsigned*)(l0 + LDSCTL_OFF))[u] = 0u;
    }
    __syncthreads();
    XcdBarrier bar = xcd_barrier_post((unsigned*)(args.ws + WS_CTL) + CW_BAR, (volatile LAS unsigned*)((LAS unsigned char*)lds_raw + MISC_OFF) + 8);
    const int lo = args.ph_lo, hi = args.ph_hi;
#define IN(k) (lo <= (k) && (k) < hi)
#ifndef PHMASK
#define PHMASK 0x7fff
#endif
#define PHEN(k) (((PHMASK) >> (k)) & 1)
#define SEAM(k) do { if (IN(k) && IN((k) + 1)) xcd_barrier(bar); } while (0)

#define PHASE_BEGIN const Args* ka = (const Args*)__builtin_amdgcn_kernarg_segment_ptr(); asm volatile("" : "+s"(ka)); unsigned char* ws = ka->ws; Frame F; mkframe(F, lds_raw); LAS char* lds = (LAS char*)F.lds; (void)lds; (void)ws;
#define TAB ((float2*)(ws + WS_TAB))
#define TABI ((float2*)(ws + WS_TABI))
#define OVM ((bf16*)(ws + WS_OVM))
#define KI ((bf16*)(ws + WS_KI))
#define CUM ((float*)(ws + WS_CUM))
#define KVC ((bf16*)(ws + WS_KVC))
#define HID ((bf16*)(ws + WS_HID))
#define SEL ((unsigned*)(ws + WS_SEL))
#define CA ((bf16*)(ws + WS_CA))
#define BM ((unsigned*)(ws + WS_BM))
#define W2T ((bf16*)(ws + WS_W2T))
#define W1T ((bf16*)(ws + WS_W1T))
#define WB ((bf16*)(ws + WS_WB))
#define WO ((bf16*)(ws + WS_WO))
#define WIN_ ((bf16*)(ws + WS_WIN))
#define WG ((bf16*)(ws + WS_WG))
#define WFI ((bf16*)(ws + WS_WFI))
#define WFO ((bf16*)(ws + WS_WFO))
#define XN ((bf16*)(ws + WS_XN))
#define BR ((bf16*)(ws + WS_BR))
#define X2 ((float*)(ws + WS_X2))
#define P ((bf16*)(ws + WS_P))
#define MG ((bf16*)(ws + WS_MG))
#define SC ((float*)(ws + WS_SC))
#define Y ((bf16*)(ws + WS_Y))
#define ACT ((bf16*)(ws + WS_ACT))
#define X1 (ka->out)
#define XIN (L == 0 ? ka->in[0] : (const float*)X2)

    { constexpr int L = 0;

        const int pb = L * NPH;
        if (PHEN(0) && IN(pb + 0)) { PHASE_BEGIN
            transpose_all<MAP_IN>(F, ka->in[2] + (size_t)L * DM * 10080, DM, 10080, NP, WIN_);
            for (int kv = 0; kv < 2; ++kv) { transpose_all<MAP_ID>(F, ka->in[7] + ((size_t)L * 2 + kv) * 4096 * 256, 4096, 256, 256, W1T + (size_t)kv * 256 * 4096);
                                             if (kv == 0) transpose_all<MAP_W2P>(F, ka->in[8] + ((size_t)L * 2 + kv) * 256 * 128, 256, 128, 256, W2T + (size_t)kv * 256 * 256);
                                             else transpose_all<MAP_W2>(F, ka->in[8] + ((size_t)L * 2 + kv) * 256 * 128, 256, 128, 256, W2T + (size_t)kv * 256 * 256); }
            if (L == 0) build_tables(F, TAB, TABI, OVM);
            for (int m = F.gw; m < S; m += F.NGW) rms_row(XIN + (size_t)m * DM, ka->in[1] + (size_t)L * DM, XN + (size_t)m * DM, nullptr, F.lane);
        }
        SEAM(pb + 0);
        if (PHEN(1) && IN(pb + 1)) { PHASE_BEGIN
            pg8::Gemm g{XN, WIN_, S, NP, DM}; pg8::StaticOrder So; So.init(S, NP, F.G, (int)blockIdx.x);
            pg8::EpiProj E{P, (const float*)TAB, (const float*)TABI};
            pg8::gemm_phase<pg8::EpiProj, pg8::StaticOrder, true, true>(F.lds, g, So, E);
        }
        SEAM(pb + 1);
        if (PHEN(2) && IN(pb + 2)) { PHASE_BEGIN prep_phase(F, P, CA, CUM, ka->in[6] + (size_t)L * 2 * 32 * 128, ka->in[5] + (size_t)L * 4); }
        SEAM(pb + 2);
        if (PHEN(3) && IN(pb + 3)) { PHASE_BEGIN
#ifndef NO_CG1
            { pg8::Gemm g{CA, W1T, 1024, 512, 4096}; pg8::StackOrder So; So.init(2, 1, 2, F.G, (int)blockIdx.x);
              pg8::EpiPlain<1> E{HID, 256, 1, 256};
              pg8::gemm_phase<pg8::EpiPlain<1>, pg8::StackOrder, true, true>(F.lds, g, So, E); }
#endif
            for (int u = blockIdx.x; u < 1056 + 384; u += F.G) {
                if (u < 1056) {
                    const int pr = u / 66, w = u % 66; int qb, kc2; if (w < 2 * (pr + 1)) { qb = pr; kc2 = w; } else { qb = 31 - pr; kc2 = w - 2 * (pr + 1); }
#ifndef NO_IDX
                    att::idx_unit(P, SC, qb, kc2, lds);
#endif
 }
                else { const int v = u - 1056; const int hh = v & 3, g = (v >> 2) % 3, blk = v / 12;
                    const int r = g == 0 ? 1 : (g == 1 ? 4 : 16); const int nper = 32 / r;
                    const int res = blk / nper, n = blk % nper; const int head = g * 4 + hh;
                    att::AttnP ap; ap.Q = P + COL_AQ + head * 128; ap.K = P + COL_AK + head * 128; ap.V = P + COL_AV + head * 128;
                    ap.O = (bf16*)(ws + WS_OA) + (size_t)g * S * 512 + hh * 128; ap.LSE = (float*)(ws + WS_LSEA) + (size_t)g * S * 4 + hh; ap.cum = nullptr; ap.bm = nullptr;
                    ap.q_pitch = NP; ap.kv_pitch = NP; ap.o_pitch = 512; ap.lse_pitch = 4;
                    ap.q_tok0 = res + r * 256 * n; ap.q_tstride = r; ap.q_sub0 = 256 * n; ap.k_tok0 = res; ap.k_tstride = r;
                    ap.j_lo = n == 0 ? 0 : 4 * n - 2; ap.j_hi = 4 * n + 4;
#ifndef NO_A
                    att::attn_unit<att::M_A, false>(ap, lds);
#endif
 }
            }
        }
        SEAM(pb + 3);
        if (PHEN(4) && IN(pb + 4)) { PHASE_BEGIN
#ifndef NO_CG2
            { pg8::Gemm g{HID, W2T, 1024, 512, 256}; pg8::StackOrder So; So.init(2, 1, 2, F.G, (int)blockIdx.x);
              pg8::EpiPlain<0> E{KVC, 128, 1, 128};
              pg8::gemm_phase<pg8::EpiPlain<0>, pg8::StackOrder, true, true>(F.lds, g, So, E); }
#endif
#ifndef NO_SEL
            for (int t = F.gw; t < S; t += F.NGW) {
                if (t < 2048) att::select_row<32>(SC, BM, t, F.lane); else if (t < 4096) att::select_row<64>(SC, BM, t, F.lane); else att::select_row<128>(SC, BM, t, F.lane);
            }
#endif
            for (int u = blockIdx.x; u < 320 + 128; u += F.G) {
                att::AttnP ap; ap.q_pitch = NP; ap.kv_pitch = NP; ap.o_pitch = 512; ap.lse_pitch = 4; ap.q_tstride = 1; ap.k_tok0 = 0; ap.k_tstride = 1; ap.bm = nullptr; ap.cum = nullptr;
                if (u < 320) { int head, qb, c; decode_bc(u, head, qb, c);
                    ap.Q = P + COL_BQ + head * 128; ap.K = P + COL_BK + head * 128; ap.V = P + COL_BV + head * 128; ap.cum = CUM + (size_t)head * S;
                    ap.O = (bf16*)(ws + WS_PB) + (size_t)c * S * 512 + head * 128; ap.LSE = (float*)(ws + WS_LSEB) + (size_t)c * S * 4 + head;
                    ap.q_tok0 = 256 * qb; ap.q_sub0 = 256 * qb; ap.j_lo = 32 * c; ap.j_hi = min(32 * c + 32, 4 * (qb + 1));
#ifndef NO_B
                    att::attn_unit<att::M_B, false>(ap, lds);
#endif
                } else { const int b = u - 320; const int q0 = 64 * b;
                    ap.Q = P + COL_DQ; ap.K = P + COL_DKW; ap.V = P + COL_DVW; ap.O = (bf16*)(ws + WS_OWIN); ap.LSE = nullptr;
                    ap.q_tok0 = q0; ap.q_sub0 = q0; ap.j_lo = q0 >= 511 ? (q0 - 511) >> 6 : 0; ap.j_hi = b + 1;
#ifndef NO_WIN
                    att::attn_unit<att::M_WIN, true>(ap, lds);
#endif
 }
            }
        }
        SEAM(pb + 4);
        if (PHEN(5) && IN(pb + 5)) { PHASE_BEGIN
            transpose_all<MAP_GATE>(F, ka->in[3] + (size_t)L * DM * 8192, DM, 8192, 8192, WG);
            for (int b = 0; b < 4; ++b) transpose_all<MAP_ID>(F, ka->in[9] + ((size_t)L * 4 + b) * 512 * DM, 512, DM, DM, WB + (size_t)b * DM * 512);
            transpose_all<MAP_ID>(F, ka->in[10] + (size_t)L * DM * DM, DM, DM, DM, WO);
            __syncthreads();
            for (int u = blockIdx.x; u < 320 + 128; u += F.G) {
                att::AttnP ap; ap.q_pitch = NP; ap.o_pitch = 512; ap.lse_pitch = 4; ap.q_tstride = 1; ap.k_tok0 = 0; ap.k_tstride = 1; ap.cum = nullptr;
                if (u < 320) { int head, qb, c; decode_bc(u, head, qb, c);
                    ap.Q = P + COL_CQ + head * 128; ap.K = P + COL_CK + head * 128; ap.V = P + COL_CV + head * 128; ap.kv_pitch = NP; ap.bm = BM;
                    ap.O = (bf16*)(ws + WS_PC) + (size_t)c * S * 512 + head * 128; ap.LSE = (float*)(ws + WS_LSEC) + (size_t)c * S * 4 + head;
                    ap.q_tok0 = 256 * qb; ap.q_sub0 = 256 * qb; ap.j_lo = 32 * c; ap.j_hi = min(32 * c + 32, 4 * (qb + 1));
#ifndef NO_C
                    att::attn_unit<att::M_C, false>(ap, lds);
#endif
                } else { const int b = u - 320; const int q0 = 64 * b;
                    ap.Q = P + COL_DQ; ap.K = KVC; ap.V = KVC + 512 * 128; ap.kv_pitch = 128; ap.bm = nullptr; ap.LSE = nullptr;
                    ap.q_tok0 = q0; ap.q_sub0 = q0; ap.j_lo = 0; ap.j_hi = 8;
#ifndef NO_CMP
                    ap.O = (bf16*)(ws + WS_OCMP); att::attn_unit<att::M_CMP, true>(ap, lds);
                    ap.V = OVM; ap.O = (bf16*)(ws + WS_IMPH); att::attn_unit<att::M_CMP, true>(ap, lds);
                    __syncthreads();
#ifndef NO_CSEL
                    cmp_select((const bf16*)(ws + WS_IMPH), SEL, q0, lds, F.tid);
#endif
#endif
 }
            }
        }
        SEAM(pb + 5);
        if (PHEN(6) && IN(pb + 6)) { PHASE_BEGIN
            for (int u = blockIdx.x; u < 320; u += F.G) { int b, c; decode_slc(u, b, c);
                att::AttnP ap; ap.q_pitch = NP; ap.kv_pitch = NP; ap.o_pitch = 512; ap.lse_pitch = 4; ap.q_tstride = 1; ap.k_tok0 = 0; ap.k_tstride = 1; ap.cum = nullptr; ap.bm = SEL;
                ap.Q = P + COL_DQ; ap.K = P + COL_DKS; ap.V = P + COL_DVS; ap.O = (bf16*)(ws + WS_PS) + (size_t)c * S * 512; ap.LSE = (float*)(ws + WS_LSES) + (size_t)c * S * 4;
                ap.q_tok0 = 64 * b; ap.q_sub0 = 64 * b; ap.j_lo = 32 * c; ap.j_hi = min(32 * c + 32, b + 1);
                att::attn_unit<att::M_SLC, true>(ap, lds); }
        }
        SEAM(pb + 6);
        if (PHEN(7) && IN(pb + 7)) { PHASE_BEGIN combine_phase(F, ws, BR); }
        SEAM(pb + 7);
        if (PHEN(8) && IN(pb + 8)) { PHASE_BEGIN
            pg8::Gemm g{BR, WB, 4 * S, 4 * DM, 512}; pg8::StackOrder So; So.init(32, 8, 4, F.G, (int)blockIdx.x);
            pg8::EpiPlain<0> E{Y, DM, 8, DM};
            pg8::gemm_phase<pg8::EpiPlain<0>, pg8::StackOrder, true, true>(F.lds, g, So, E);
        }
        SEAM(pb + 8);
        if (PHEN(9) && IN(pb + 9)) { PHASE_BEGIN
            pg8::Gemm g{XN, WG, S, 8192, DM}; pg8::StaticOrder So; So.init(S, 8192, F.G, (int)blockIdx.x);
            pg8::EpiGate E{Y, ka->in[4] + (size_t)L * 4 * DM, MG};
            pg8::gemm_phase<pg8::EpiGate, pg8::StaticOrder, true, true>(F.lds, g, So, E);
        }
        SEAM(pb + 9);
        if (PHEN(10) && IN(pb + 10)) { PHASE_BEGIN
            pg8::Gemm g{MG, WO, S, DM, DM}; pg8::StaticOrder So; So.init(S, DM, F.G, (int)blockIdx.x);
            pg8::EpiRes E{XIN, X1};
            pg8::gemm_phase<pg8::EpiRes, pg8::StaticOrder, true, true>(F.lds, g, So, E);
        }
        SEAM(pb + 10);
        if (PHEN(11) && IN(pb + 11)) { PHASE_BEGIN
            transpose_all<MAP_FFI>(F, ka->in[12] + (size_t)L * DM * NFF2, DM, NFF2, NFF2, WFI);
            transpose_all<MAP_ID>(F, ka->in[13] + (size_t)L * NFF * DM, NFF, DM, DM, WFO);
            for (int m = F.gw; m < S; m += F.NGW) rms_row(X1 + (size_t)m * DM, ka->in[11] + (size_t)L * DM, XN + (size_t)m * DM, nullptr, F.lane); }
        SEAM(pb + 11);
        if (PHEN(12) && IN(pb + 12)) { PHASE_BEGIN
            pg8::Gemm g{XN, WFI, S, NFF2, DM}; pg8::StaticOrder So; So.init(S, NFF2, F.G, (int)blockIdx.x);
            pg8::EpiSwiglu E{ACT};
            pg8::gemm_phase<pg8::EpiSwiglu, pg8::StaticOrder, true, true>(F.lds, g, So, E);
        }
        SEAM(pb + 12);
        if (PHEN(13) && IN(pb + 13)) { PHASE_BEGIN
            pg8::Gemm g{ACT, WFO, S, DM, NFF}; pg8::StaticOrder So; So.init(S, DM, F.G, (int)blockIdx.x);
            pg8::EpiRes E{X1, X2};
            pg8::gemm_phase<pg8::EpiRes, pg8::StaticOrder, true, true>(F.lds, g, So, E);
        }
        SEAM(pb + 13);

    }
    { constexpr int L = 1;

        const int pb = L * NPH;
        if (PHEN(0) && IN(pb + 0)) { PHASE_BEGIN
            transpose_all<MAP_IN>(F, ka->in[2] + (size_t)L * DM * 10080, DM, 10080, NP, WIN_);
            for (int kv = 0; kv < 2; ++kv) { transpose_all<MAP_ID>(F, ka->in[7] + ((size_t)L * 2 + kv) * 4096 * 256, 4096, 256, 256, W1T + (size_t)kv * 256 * 4096);
                                             if (kv == 0) transpose_all<MAP_W2P>(F, ka->in[8] + ((size_t)L * 2 + kv) * 256 * 128, 256, 128, 256, W2T + (size_t)kv * 256 * 256);
                                             else transpose_all<MAP_W2>(F, ka->in[8] + ((size_t)L * 2 + kv) * 256 * 128, 256, 128, 256, W2T + (size_t)kv * 256 * 256); }
            if (L == 0) build_tables(F, TAB, TABI, OVM);
            for (int m = F.gw; m < S; m += F.NGW) rms_row(XIN + (size_t)m * DM, ka->in[1] + (size_t)L * DM, XN + (size_t)m * DM, nullptr, F.lane);
        }
        SEAM(pb + 0);
        if (PHEN(1) && IN(pb + 1)) { PHASE_BEGIN
            pg8::Gemm g{XN, WIN_, S, NP, DM}; pg8::StaticOrder So; So.init(S, NP, F.G, (int)blockIdx.x);
            pg8::EpiProj E{P, (const float*)TAB, (const float*)TABI};
            pg8::gemm_phase<pg8::EpiProj, pg8::StaticOrder, true, true>(F.lds, g, So, E);
        }
        SEAM(pb + 1);
        if (PHEN(2) && IN(pb + 2)) { PHASE_BEGIN prep_phase(F, P, CA, CUM, ka->in[6] + (size_t)L * 2 * 32 * 128, ka->in[5] + (size_t)L * 4); }
        SEAM(pb + 2);
        if (PHEN(3) && IN(pb + 3)) { PHASE_BEGIN
#ifndef NO_CG1
            { pg8::Gemm g{CA, W1T, 1024, 512, 4096}; pg8::StackOrder So; So.init(2, 1, 2, F.G, (int)blockIdx.x);
              pg8::EpiPlain<1> E{HID, 256, 1, 256};
              pg8::gemm_phase<pg8::EpiPlain<1>, pg8::StackOrder, true, true>(F.lds, g, So, E); }
#endif
            for (int u = blockIdx.x; u < 1056 + 384; u += F.G) {
                if (u < 1056) {
                    const int pr = u / 66, w = u % 66; int qb, kc2; if (w < 2 * (pr + 1)) { qb = pr; kc2 = w; } else { qb = 31 - pr; kc2 = w - 2 * (pr + 1); }
#ifndef NO_IDX
                    att::idx_unit(P, SC, qb, kc2, lds);
#endif
 }
                else { const int v = u - 1056; const int hh = v & 3, g = (v >> 2) % 3, blk = v / 12;
                    const int r = g == 0 ? 1 : (g == 1 ? 4 : 16); const int nper = 32 / r;
                    const int res = blk / nper, n = blk % nper; const int head = g * 4 + hh;
                    att::AttnP ap; ap.Q = P + COL_AQ + head * 128; ap.K = P + COL_AK + head * 128; ap.V = P + COL_AV + head * 128;
                    ap.O = (bf16*)(ws + WS_OA) + (size_t)g * S * 512 + hh * 128; ap.LSE = (float*)(ws + WS_LSEA) + (size_t)g * S * 4 + hh; ap.cum = nullptr; ap.bm = nullptr;
                    ap.q_pitch = NP; ap.kv_pitch = NP; ap.o_pitch = 512; ap.lse_pitch = 4;
                    ap.q_tok0 = res + r * 256 * n; ap.q_tstride = r; ap.q_sub0 = 256 * n; ap.k_tok0 = res; ap.k_tstride = r;
                    ap.j_lo = n == 0 ? 0 : 4 * n - 2; ap.j_hi = 4 * n + 4;
#ifndef NO_A
                    att::attn_unit<att::M_A, false>(ap, lds);
#endif
 }
            }
        }
        SEAM(pb + 3);
        if (PHEN(4) && IN(pb + 4)) { PHASE_BEGIN
#ifndef NO_CG2
            { pg8::Gemm g{HID, W2T, 1024, 512, 256}; pg8::StackOrder So; So.init(2, 1, 2, F.G, (int)blockIdx.x);
              pg8::EpiPlain<0> E{KVC, 128, 1, 128};
              pg8::gemm_phase<pg8::EpiPlain<0>, pg8::StackOrder, true, true>(F.lds, g, So, E); }
#endif
#ifndef NO_SEL
            for (int t = F.gw; t < S; t += F.NGW) {
                if (t < 2048) att::select_row<32>(SC, BM, t, F.lane); else if (t < 4096) att::select_row<64>(SC, BM, t, F.lane); else att::select_row<128>(SC, BM, t, F.lane);
            }
#endif
            for (int u = blockIdx.x; u < 320 + 128; u += F.G) {
                att::AttnP ap; ap.q_pitch = NP; ap.kv_pitch = NP; ap.o_pitch = 512; ap.lse_pitch = 4; ap.q_tstride = 1; ap.k_tok0 = 0; ap.k_tstride = 1; ap.bm = nullptr; ap.cum = nullptr;
                if (u < 320) { int head, qb, c; decode_bc(u, head, qb, c);
                    ap.Q = P + COL_BQ + head * 128; ap.K = P + COL_BK + head * 128; ap.V = P + COL_BV + head * 128; ap.cum = CUM + (size_t)head * S;
                    ap.O = (bf16*)(ws + WS_PB) + (size_t)c * S * 512 + head * 128; ap.LSE = (float*)(ws + WS_LSEB) + (size_t)c * S * 4 + head;
                    ap.q_tok0 = 256 * qb; ap.q_sub0 = 256 * qb; ap.j_lo = 32 * c; ap.j_hi = min(32 * c + 32, 4 * (qb + 1));
#ifndef NO_B
                    att::attn_unit<att::M_B, false>(ap, lds);
#endif
                } else { const int b = u - 320; const int q0 = 64 * b;
                    ap.Q = P + COL_DQ; ap.K = P + COL_DKW; ap.V = P + COL_DVW; ap.O = (bf16*)(ws + WS_OWIN); ap.LSE = nullptr;
                    ap.q_tok0 = q0; ap.q_sub0 = q0; ap.j_lo = q0 >= 511 ? (q0 - 511) >> 6 : 0; ap.j_hi = b + 1;
#ifndef NO_WIN
                    att::attn_unit<att::M_WIN, true>(ap, lds);
#endif
 }
            }
        }
        SEAM(pb + 4);
        if (PHEN(5) && IN(pb + 5)) { PHASE_BEGIN
            transpose_all<MAP_GATE>(F, ka->in[3] + (size_t)L * DM * 8192, DM, 8192, 8192, WG);
            for (int b = 0; b < 4; ++b) transpose_all<MAP_ID>(F, ka->in[9] + ((size_t)L * 4 + b) * 512 * DM, 512, DM, DM, WB + (size_t)b * DM * 512);
            transpose_all<MAP_ID>(F, ka->in[10] + (size_t)L * DM * DM, DM, DM, DM, WO);
            __syncthreads();
            for (int u = blockIdx.x; u < 320 + 128; u += F.G) {
                att::AttnP ap; ap.q_pitch = NP; ap.o_pitch = 512; ap.lse_pitch = 4; ap.q_tstride = 1; ap.k_tok0 = 0; ap.k_tstride = 1; ap.cum = nullptr;
                if (u < 320) { int head, qb, c; decode_bc(u, head, qb, c);
                    ap.Q = P + COL_CQ + head * 128; ap.K = P + COL_CK + head * 128; ap.V = P + COL_CV + head * 128; ap.kv_pitch = NP; ap.bm = BM;
                    ap.O = (bf16*)(ws + WS_PC) + (size_t)c * S * 512 + head * 128; ap.LSE = (float*)(ws + WS_LSEC) + (size_t)c * S * 4 + head;
                    ap.q_tok0 = 256 * qb; ap.q_sub0 = 256 * qb; ap.j_lo = 32 * c; ap.j_hi = min(32 * c + 32, 4 * (qb + 1));
#ifndef NO_C
                    att::attn_unit<att::M_C, false>(ap, lds);
#endif
                } else { const int b = u - 320; const int q0 = 64 * b;
                    ap.Q = P + COL_DQ; ap.K = KVC; ap.V = KVC + 512 * 128; ap.kv_pitch = 128; ap.bm = nullptr; ap.LSE = nullptr;
                    ap.q_tok0 = q0; ap.q_sub0 = q0; ap.j_lo = 0; ap.j_hi = 8;
#ifndef NO_CMP
                    ap.O = (bf16*)(ws + WS_OCMP); att::attn_unit<att::M_CMP, true>(ap, lds);
                    ap.V = OVM; ap.O = (bf16*)(ws + WS_IMPH); att::attn_unit<att::M_CMP, true>(ap, lds);
                    __syncthreads();
#ifndef NO_CSEL
                    cmp_select((const bf16*)(ws + WS_IMPH), SEL, q0, lds, F.tid);
#endif
#endif
 }
            }
        }
        SEAM(pb + 5);
        if (PHEN(6) && IN(pb + 6)) { PHASE_BEGIN
            for (int u = blockIdx.x; u < 320; u += F.G) { int b, c; decode_slc(u, b, c);
                att::AttnP ap; ap.q_pitch = NP; ap.kv_pitch = NP; ap.o_pitch = 512; ap.lse_pitch = 4; ap.q_tstride = 1; ap.k_tok0 = 0; ap.k_tstride = 1; ap.cum = nullptr; ap.bm = SEL;
                ap.Q = P + COL_DQ; ap.K = P + COL_DKS; ap.V = P + COL_DVS; ap.O = (bf16*)(ws + WS_PS) + (size_t)c * S * 512; ap.LSE = (float*)(ws + WS_LSES) + (size_t)c * S * 4;
                ap.q_tok0 = 64 * b; ap.q_sub0 = 64 * b; ap.j_lo = 32 * c; ap.j_hi = min(32 * c + 32, b + 1);
                att::attn_unit<att::M_SLC, true>(ap, lds); }
        }
        SEAM(pb + 6);
        if (PHEN(7) && IN(pb + 7)) { PHASE_BEGIN combine_phase(F, ws, BR); }
        SEAM(pb + 7);
        if (PHEN(8) && IN(pb + 8)) { PHASE_BEGIN
            pg8::Gemm g{BR, WB, 4 * S, 4 * DM, 512}; pg8::StackOrder So; So.init(32, 8, 4, F.G, (int)blockIdx.x);
            pg8::EpiPlain<0> E{Y, DM, 8, DM};
            pg8::gemm_phase<pg8::EpiPlain<0>, pg8::StackOrder, true, true>(F.lds, g, So, E);
        }
        SEAM(pb + 8);
        if (PHEN(9) && IN(pb + 9)) { PHASE_BEGIN
            pg8::Gemm g{XN, WG, S, 8192, DM}; pg8::StaticOrder So; So.init(S, 8192, F.G, (int)blockIdx.x);
            pg8::EpiGate E{Y, ka->in[4] + (size_t)L * 4 * DM, MG};
            pg8::gemm_phase<pg8::EpiGate, pg8::StaticOrder, true, true>(F.lds, g, So, E);
        }
        SEAM(pb + 9);
        if (PHEN(10) && IN(pb + 10)) { PHASE_BEGIN
            pg8::Gemm g{MG, WO, S, DM, DM}; pg8::StaticOrder So; So.init(S, DM, F.G, (int)blockIdx.x);
            pg8::EpiRes E{XIN, X1};
            pg8::gemm_phase<pg8::EpiRes, pg8::StaticOrder, true, true>(F.lds, g, So, E);
        }
        SEAM(pb + 10);
        if (PHEN(11) && IN(pb + 11)) { PHASE_BEGIN
            transpose_all<MAP_FFI>(F, ka->in[12] + (size_t)L * DM * NFF2, DM, NFF2, NFF2, WFI);
            transpose_all<MAP_ID>(F, ka->in[13] + (size_t)L * NFF * DM, NFF, DM, DM, WFO);
            for (int m = F.gw; m < S; m += F.NGW) rms_row(X1 + (size_t)m * DM, ka->in[11] + (size_t)L * DM, XN + (size_t)m * DM, nullptr, F.lane); }
        SEAM(pb + 11);
        if (PHEN(12) && IN(pb + 12)) { PHASE_BEGIN
            pg8::Gemm g{XN, WFI, S, NFF2, DM}; pg8::StaticOrder So; So.init(S, NFF2, F.G, (int)blockIdx.x);
            pg8::EpiSwiglu E{ACT};
            pg8::gemm_phase<pg8::EpiSwiglu, pg8::StaticOrder, true, true>(F.lds, g, So, E);
        }
        SEAM(pb + 12);
        if (PHEN(13) && IN(pb + 13)) { PHASE_BEGIN
            pg8::Gemm g{ACT, WFO, S, DM, NFF}; pg8::StaticOrder So; So.init(S, DM, F.G, (int)blockIdx.x);
            pg8::EpiRes E{X1, X2};
            pg8::gemm_phase<pg8::EpiRes, pg8::StaticOrder, true, true>(F.lds, g, So, E);
        }
        SEAM(pb + 13);

    }
#ifdef HYB_PROBE_OFF
    {
        if (hi > 0) xcd_barrier(bar);
        const Args* ka = (const Args*)__builtin_amdgcn_kernarg_segment_ptr(); const bf16* src = (const bf16*)(ka->ws + (size_t)(HYB_PROBE_OFF));
        for (size_t i = (size_t)blockIdx.x * 512 + threadIdx.x; i < (size_t)S * DM; i += (size_t)gridDim.x * 512) { const size_t t = i / DM, c = i % DM; const size_t si = (t * (HYB_PROBE_PITCH) + c) % (size_t)(HYB_PROBE_MOD);
#ifdef HYB_PROBE_BM
            { const unsigned w = (unsigned)(c & 255); const unsigned v = (w < 8u * ((unsigned)(t >> 8) + 1u)) ? ((const unsigned*)src)[t * 256 + w] : 0u; ka->out[i] = (float)(v & 0xffffu) + (float)(v >> 16) * (1.0f / 65536.0f); (void)si; }
#elif defined(HYB_PROBE_F32)
            ka->out[i] = ((const float*)src)[si];
#elif defined(HYB_PROBE_U32)
            ka->out[i] = (float)(((const unsigned*)src)[si] & 0xffffu) + (float)(((const unsigned*)src)[si] >> 16) * (1.0f / 65536.0f);
#else
            ka->out[i] = bf2f(src[si]);
#endif
 }
        return;
    }
#endif
    if (PHEN(14) && IN(PH_FINAL)) { const int L = 1; (void)L; PHASE_BEGIN for (int m = F.gw; m < S; m += F.NGW) rms_row(X2 + (size_t)m * DM, ka->in[14], nullptr, ka->out + (size_t)m * DM, F.lane); }
#undef IN
#undef SEAM
}

#ifndef HYB_N_LAUNCHES
#define HYB_N_LAUNCHES 1
#endif
extern "C" void kernel_launch(void* const* d_in, const int* in_sizes, int n_in, void* d_out, int out_size, void* d_ws, size_t ws_size, hipStream_t stream) {
    static int grid = 0;
    if (grid == 0) {
        if (n_in != 15 || out_size != S * DM || ws_size < WS_END) { fprintf(stderr, "kernel_launch: unexpected shapes: n_in %d out %d ws %zu (need %zu)\n", n_in, out_size, ws_size, (size_t)WS_END); grid = -1; return; }
        int dev = 0, cus = 0, per_cu = 0;
        if (hipGetDevice(&dev) != hipSuccess || hipDeviceGetAttribute(&cus, hipDeviceAttributeMultiprocessorCount, dev) != hipSuccess) { grid = -1; return; }
        if (hipFuncSetAttribute((const void*)hyb_fwd, hipFuncAttributeMaxDynamicSharedMemorySize, LDS_BYTES) != hipSuccess) { fprintf(stderr, "kernel_launch: hipFuncSetAttribute failed\n"); grid = -1; return; }
        if (hipOccupancyMaxActiveBlocksPerMultiprocessor(&per_cu, (const void*)hyb_fwd, NWAVES * 64, LDS_BYTES) != hipSuccess || per_cu < 1) { fprintf(stderr, "kernel_launch: occupancy query says %d\n", per_cu); }
        (void)hipGetLastError();
        grid = cus;
    }
    if (grid < 0) return;
    if (hipMemsetAsync((char*)d_ws + WS_CTL, 0, CTL_ZERO_BYTES, stream) != hipSuccess) return;
    Args a{};
    for (int i = 0; i < 15; ++i) a.in[i] = (const float*)d_in[i];
    a.out = (float*)d_out; a.ws = (unsigned char*)d_ws;
#if HYB_N_LAUNCHES == 1
#ifndef HYB_PH_HI
#define HYB_PH_HI PH_END
#endif
    a.ph_lo = 0; a.ph_hi = HYB_PH_HI;
    hipLaunchKernelGGL(hyb_fwd, dim3(grid), dim3(NWAVES * 64), LDS_BYTES, stream, a);
#else
    for (int ph = 0; ph < PH_END; ++ph) { a.ph_lo = ph; a.ph_hi = ph + 1; hipLaunchKernelGGL(hyb_fwd, dim3(grid), dim3(NWAVES * 64), LDS_BYTES, stream, a); }
#endif
}
```

```cpp
#include <hip/hip_runtime.h>
#include <cstdio>
#include <cstdint>
namespace pg8 {
#define PG8_LAS __attribute__((address_space(3)))
typedef unsigned short bf16_t;
typedef short bf16x8 __attribute__((ext_vector_type(8)));
typedef float f32x4 __attribute__((ext_vector_type(4)));
typedef unsigned u32x4 __attribute__((ext_vector_type(4)));
constexpr int BM = 256, BK = 64, HALF = 128, HTB = HALF * BK * 2  , STAGE_BYTES = 8 * HTB, NXCD = 8, WGM = 8;

__host__ __device__ __forceinline__ int lds_byte(int r, int c) { const int st = (r >> 4) * 2 + (c >> 5), rr = r & 15, cc = c & 31, ob = rr * 64 + cc * 2; return st * 1024 + (ob ^ (((ob >> 9) & 1) << 5)); }
__host__ __device__ __forceinline__ void stage_rc(int b, int& R, int& C) { const int st = b / 1024, sb = b % 1024, swz = sb ^ (((sb >> 9) & 1) << 5); R = (st >> 1) * 16 + swz / 64; C = (st & 1) * 32 + (swz % 64) / 2; }
__host__ __device__ __forceinline__ int perm32(int rho) { const int n = rho >> 4, i = rho & 15; return 8 * (i >> 2) + 4 * n + (i & 3); }

struct Unit { int pm, pn, ko; };
struct Gemm { const bf16_t* A; const bf16_t* Bt; int M, N, K; int KL; };

struct StaticOrder {
    int nM, nN, nwg, G, c;
    __host__ __device__ void init(int M, int N, int G_, int c_) { nM = M / BM; nN = N / BM; nwg = nM * nN; G = G_; c = c_; }
    __host__ __device__ bool next(int i, Unit& u) const {
        const long L = (long)i * G + c; if (L >= nwg) return false;
        int wgid = (int)L; { const int q = nwg / NXCD, r = nwg % NXCD, xcd = wgid % NXCD, off = wgid / NXCD; wgid = (xcd < r ? xcd * (q + 1) : r * (q + 1) + (xcd - r) * q) + off; }
        const int nig = WGM * nN, gid = wgid / nig, fm = gid * WGM, gsz = (nM - fm) < WGM ? (nM - fm) : WGM;
        u.pm = fm + ((wgid % nig) % gsz); u.pn = (wgid % nig) / gsz; u.ko = 0; return true;
    }
    __device__ __forceinline__ void a_ready(const Unit&) const {}
    __device__ __forceinline__ void done(const Unit&) const {}
};

__device__ __forceinline__ unsigned cvt_pk_bf16(float lo, float hi) { unsigned r; asm volatile("v_cvt_pk_bf16_f32 %0, %1, %2" : "=v"(r) : "v"(lo), "v"(hi)); return r; }
typedef float f32x2 __attribute__((ext_vector_type(2)));
template <class Epi, class Sched, bool ALIGN_EPI = false, bool SP2 = false>
__device__ __forceinline__ void gemm_phase(PG8_LAS unsigned char* lds, const Gemm g, const Sched& S, const Epi& E) {
    int tid_ = threadIdx.x; asm volatile("" : "+v"(tid_));
    const int tid = tid_, wid = __builtin_amdgcn_readfirstlane(tid >> 6), lane = tid & 63, wr = wid >> 2, wc = wid & 3, fr = lane & 15, fq = lane >> 4;
    const int K = g.K, nt = g.KL / BK;
    unsigned voffA[2], voffB[2];
#pragma unroll
    for (int i = 0; i < 2; ++i) { int R, C; stage_rc(tid * 16 + i * 8192, R, C); const int Rb = Epi::PERM ? ((R & ~31) + perm32(R & 31)) : R;
        voffA[i] = (unsigned)(R * K + C) * 2u; voffB[i] = (unsigned)(Rb * K + C) * 2u; }
    const size_t kstep = (size_t)(BK * 2);
    const size_t hstep = (size_t)HALF * K * 2;
    const size_t tstep = 2 * hstep;
    const unsigned ldsw = (unsigned)wid * 1024u;
    const int aoff = lds_byte(wr * 64 + fr, fq * 8), boff = lds_byte(wc * 32 + fr, fq * 8);
#define PG8_SA(b, h) (((b) * 2 + (h)) * HTB)
#define PG8_SB(b, h) ((4 + (b) * 2 + (h)) * HTB)
#define PG8_STAGE(bufoff, gbase, voff) do { _Pragma("unroll") for (int _i = 0; _i < 2; ++_i) \
        __builtin_amdgcn_global_load_lds((const unsigned*)((const char*)(gbase) + (voff)[_i]), (PG8_LAS unsigned*)(lds + (bufoff) + ldsw + _i * 8192), 16, 0, 0); } while (0)
#define PG8_LDA(dst, b, h) do { _Pragma("unroll") for (int m = 0; m < 4; ++m) _Pragma("unroll") for (int k = 0; k < 2; ++k) dst[m][k] = *(const PG8_LAS bf16x8*)(lds + PG8_SA(b, h) + aoff + m * 2048 + k * 1024); } while (0)
#define PG8_LDB(dst, b, h) do { _Pragma("unroll") for (int n = 0; n < 2; ++n) _Pragma("unroll") for (int k = 0; k < 2; ++k) dst[n][k] = *(const PG8_LAS bf16x8*)(lds + PG8_SB(b, h) + boff + n * 2048 + k * 1024); } while (0)
#define PG8_MMA(ai, bj, At, Bt) do { __builtin_amdgcn_s_setprio(1); _Pragma("unroll") for (int m = 0; m < 4; ++m) _Pragma("unroll") for (int n = 0; n < 2; ++n) _Pragma("unroll") for (int k = 0; k < 2; ++k) \
        acc[ai][bj][m][n] = __builtin_amdgcn_mfma_f32_16x16x32_bf16(Bt[n][k], At[m][k], acc[ai][bj][m][n], 0, 0, 0); __builtin_amdgcn_s_setprio(0); } while (0)
#define PG8_WAIT_V(n) asm volatile("s_waitcnt vmcnt(" #n ")" ::: "memory")
#define PG8_WAIT_L(n) asm volatile("s_waitcnt lgkmcnt(" #n ")" ::: "memory")
#define PG8_BAR __builtin_amdgcn_s_barrier()
#define PG8_SCHED __builtin_amdgcn_sched_barrier(0)
    Unit cur, nxt; int ui = 0;
    if (!S.next(0, cur)) return;
    f32x4 acc[2][2][4][2];
#pragma unroll
    for (int a = 0; a < 2; ++a)
#pragma unroll
        for (int b = 0; b < 2; ++b)
#pragma unroll
            for (int m = 0; m < 4; ++m)
#pragma unroll
                for (int n = 0; n < 2; ++n) acc[a][b][m][n] = (f32x4){0.f, 0.f, 0.f, 0.f};
    bf16x8 At[4][2], B0[2][2], B1[2][2];
    const char* cA = (const char*)g.A + (size_t)cur.pm * tstep + (size_t)cur.ko * 2; const char* cB = (const char*)g.Bt + (size_t)cur.pn * tstep + (size_t)cur.ko * 2;
    S.a_ready(cur);
    if constexpr (SP2) {
        PG8_STAGE(PG8_SB(0, 0), cB, voffB); PG8_STAGE(PG8_SB(0, 1), cB + hstep, voffB); PG8_STAGE(PG8_SA(0, 0), cA, voffA); PG8_STAGE(PG8_SA(0, 1), cA + hstep, voffA);
        if (wr == 1) PG8_BAR;
        PG8_WAIT_V(2); PG8_BAR;
        PG8_STAGE(PG8_SB(1, 0), cB + kstep, voffB); PG8_STAGE(PG8_SA(1, 0), cA + kstep, voffA); PG8_STAGE(PG8_SB(1, 1), cB + hstep + kstep, voffB);
        PG8_WAIT_V(6); PG8_BAR;
    } else {
        PG8_STAGE(PG8_SB(0, 0), cB, voffB); PG8_STAGE(PG8_SA(0, 0), cA, voffA); PG8_STAGE(PG8_SB(0, 1), cB + hstep, voffB); PG8_STAGE(PG8_SA(0, 1), cA + hstep, voffA);
        if (wr == 1) PG8_BAR;
        PG8_WAIT_V(4); PG8_BAR;
        PG8_STAGE(PG8_SB(1, 0), cB + kstep, voffB); PG8_STAGE(PG8_SA(1, 0), cA + kstep, voffA); PG8_STAGE(PG8_SB(1, 1), cB + hstep + kstep, voffB);
        PG8_WAIT_V(6); PG8_BAR;
    }
    for (;;) {
        const bool has_next = S.next(ui + 1, nxt);
        const char* nA = has_next ? (const char*)g.A + (size_t)nxt.pm * tstep + (size_t)nxt.ko * 2 : cA; const char* nB = has_next ? (const char*)g.Bt + (size_t)nxt.pn * tstep + (size_t)nxt.ko * 2 : cB;
        for (int t = 0; t < nt; t += 2) {
            const bool last = (t == nt - 2);
            const char* a1 = cA + (size_t)(t + 1) * kstep;
            const char* a2 = last ? nA : cA + (size_t)(t + 2) * kstep; const char* b2 = last ? nB : cB + (size_t)(t + 2) * kstep;
            const char* a3 = a2 + kstep; const char* b3 = b2 + kstep;
            if (last && has_next) S.a_ready(nxt);
            if constexpr (SP2) {
            PG8_LDB(B0, 0, 0); PG8_LDB(B1, 0, 1); PG8_SCHED; PG8_LDA(At, 0, 0); PG8_STAGE(PG8_SA(1, 1), a1 + hstep, voffA);
            PG8_WAIT_V(8); PG8_WAIT_L(0); PG8_BAR; PG8_MMA(0, 0, At, B0); PG8_MMA(0, 1, At, B1); PG8_BAR; PG8_SCHED;
            PG8_LDA(At, 0, 1); PG8_STAGE(PG8_SB(0, 0), b2, voffB); PG8_STAGE(PG8_SB(0, 1), b2 + hstep, voffB); PG8_STAGE(PG8_SA(0, 0), a2, voffA);
            PG8_WAIT_V(8); PG8_WAIT_L(0); PG8_BAR; PG8_MMA(1, 0, At, B0); PG8_MMA(1, 1, At, B1); PG8_BAR; PG8_SCHED;
            PG8_LDB(B0, 1, 0); PG8_LDB(B1, 1, 1); PG8_SCHED; PG8_LDA(At, 1, 0); PG8_STAGE(PG8_SA(0, 1), a2 + hstep, voffA);
            PG8_WAIT_V(8); PG8_WAIT_L(0); PG8_BAR; PG8_MMA(0, 0, At, B0); PG8_MMA(0, 1, At, B1); PG8_BAR; PG8_SCHED;
            PG8_LDA(At, 1, 1); PG8_STAGE(PG8_SB(1, 0), b3, voffB); PG8_STAGE(PG8_SB(1, 1), b3 + hstep, voffB); PG8_STAGE(PG8_SA(1, 0), a3, voffA);
            PG8_WAIT_V(8); PG8_WAIT_L(0); PG8_BAR; PG8_MMA(1, 0, At, B0); PG8_MMA(1, 1, At, B1); PG8_BAR; PG8_SCHED;
            } else {
            PG8_LDB(B0, 0, 0); PG8_SCHED; PG8_LDA(At, 0, 0); PG8_STAGE(PG8_SA(1, 1), a1 + hstep, voffA);
            PG8_WAIT_L(8); PG8_BAR; PG8_WAIT_L(0); PG8_MMA(0, 0, At, B0); PG8_BAR; PG8_SCHED;
            PG8_LDB(B1, 0, 1); PG8_STAGE(PG8_SB(0, 0), b2, voffB);
            PG8_BAR; PG8_WAIT_L(0); PG8_MMA(0, 1, At, B1); PG8_BAR;
            PG8_LDA(At, 0, 1); PG8_STAGE(PG8_SA(0, 0), a2, voffA);
            PG8_BAR; PG8_WAIT_L(0); PG8_MMA(1, 0, At, B0); PG8_BAR; PG8_SCHED;
            PG8_STAGE(PG8_SB(0, 1), b2 + hstep, voffB);
            PG8_WAIT_V(6); PG8_BAR; PG8_MMA(1, 1, At, B1); PG8_BAR;
            PG8_LDB(B0, 1, 0); PG8_SCHED; PG8_LDA(At, 1, 0); PG8_STAGE(PG8_SA(0, 1), a2 + hstep, voffA);
            PG8_WAIT_L(8); PG8_BAR; PG8_WAIT_L(0); PG8_MMA(0, 0, At, B0); PG8_BAR; PG8_SCHED;
            PG8_LDB(B1, 1, 1); PG8_STAGE(PG8_SB(1, 0), b3, voffB);
            PG8_BAR; PG8_WAIT_L(0); PG8_MMA(0, 1, At, B1); PG8_BAR;
            PG8_LDA(At, 1, 1); PG8_STAGE(PG8_SA(1, 0), a3, voffA);
            PG8_BAR; PG8_WAIT_L(0); PG8_MMA(1, 0, At, B0); PG8_BAR; PG8_SCHED;
            PG8_STAGE(PG8_SB(1, 1), b3 + hstep, voffB);
            PG8_WAIT_V(6); PG8_BAR; PG8_MMA(1, 1, At, B1); PG8_BAR;
            }
        }
        if constexpr (ALIGN_EPI) { if (wr == 0) PG8_BAR; }
        if constexpr (!Epi::AFTER_DRAIN) { E(acc, cur, wr, wc, fr, fq); S.done(cur); }
        if (!has_next) break;
#pragma unroll
        for (int a = 0; a < 2; ++a)
#pragma unroll
            for (int b = 0; b < 2; ++b)
#pragma unroll
                for (int m = 0; m < 4; ++m)
#pragma unroll
                    for (int n = 0; n < 2; ++n) acc[a][b][m][n] = (f32x4){0.f, 0.f, 0.f, 0.f};
        cur = nxt; cA = nA; cB = nB; ++ui;
        if constexpr (ALIGN_EPI) { if (wr == 1) PG8_BAR; }
    }
    PG8_WAIT_V(0);
    if constexpr (!ALIGN_EPI) { if (wr == 0) PG8_BAR; }
    PG8_BAR;
    if constexpr (Epi::AFTER_DRAIN) { E.fused(acc, cur, wr, wc, fr, fq, lds, wid, lane); S.done(cur); }
#undef PG8_SA
#undef PG8_SB
#undef PG8_STAGE
#undef PG8_LDA
#undef PG8_LDB
#undef PG8_MMA
#undef PG8_WAIT_V
#undef PG8_WAIT_L
#undef PG8_BAR
#undef PG8_SCHED
}
}
constexpr int S = 8192, DM = 2048, NP = 10240, NFF = 5632, NFF2 = 11264;
constexpr int COL_AQ = 0, COL_AK = 1536, COL_AV = 3072, COL_BQ = 4608, COL_BK = 5120, COL_BV = 5632, COL_CQ = 6144, COL_CK = 6656, COL_CV = 7168,
              COL_CQI = 7680, COL_DQ = 8704, COL_DKC = 9216, COL_DVC = 9344, COL_DKS = 9472, COL_DVS = 9600, COL_DKW = 9728, COL_DVW = 9856, COL_MISC = 9984;
constexpr int MI_CKI = 0, MI_BFL = 64, MI_CWI = 68, MI_DG = 84;

namespace pg8 {
struct EpiProj {
    static constexpr bool PERM = true, AFTER_DRAIN = false;
    bf16_t* P; const float* TAB; const float* TABI;
    __device__ __forceinline__ void operator()(const f32x4 (&acc)[2][2][4][2], const Unit& u, int wr, int wc, int fr, int fq) const {
        const int row0 = u.pm * BM + wr * 64 + fr; const int col0 = u.pn * BM + wc * 32 + 8 * fq; const int pn = u.pn;
        int mode0, mode1;
        if (pn < 12 || (pn >= 24 && pn < 28) || pn == 34 || pn == 35) { mode0 = 1; mode1 = 1; }
        else if (pn >= 30 && pn < 34) { mode0 = 2; mode1 = 2; }
        else if (pn >= 36 && pn < 39) { mode0 = 1; mode1 = 0; }
        else if (pn == 39) { mode0 = wc < 2 ? 2 : 0; mode1 = 0; }
        else { mode0 = 0; mode1 = 0; }
#pragma unroll
        for (int ai = 0; ai < 2; ++ai)
#pragma unroll
            for (int m = 0; m < 4; ++m) { const int row = row0 + ai * HALF + m * 16; bf16_t* rowp = P + (size_t)row * NP + col0;
#pragma unroll
                for (int bj = 0; bj < 2; ++bj) { f32x4 v0 = acc[ai][bj][m][0], v1 = acc[ai][bj][m][1]; const int mode = bj ? mode1 : mode0;
                    if (mode != 0) {
                        const float* tp = mode == 1 ? TAB + ((size_t)row * 64 + 4 * (4 * wc + fq)) * 2 : TABI + ((size_t)row * 32 + 4 * (4 * (wc & 1) + fq)) * 2;
                        const f32x4 t0 = *(const f32x4*)tp, t1 = *(const f32x4*)(tp + 4);
                        f32x4 r0, r1;
                        r0[0] = v0[0] * t0[0] - v0[1] * t0[1]; r0[1] = v0[1] * t0[0] + v0[0] * t0[1]; r0[2] = v0[2] * t0[2] - v0[3] * t0[3]; r0[3] = v0[3] * t0[2] + v0[2] * t0[3];
                        r1[0] = v1[0] * t1[0] - v1[1] * t1[1]; r1[1] = v1[1] * t1[0] + v1[0] * t1[1]; r1[2] = v1[2] * t1[2] - v1[3] * t1[3]; r1[3] = v1[3] * t1[2] + v1[2] * t1[3];
                        v0 = r0; v1 = r1; }
                    u32x4 w; w.x = cvt_pk_bf16(v0[0], v0[1]); w.y = cvt_pk_bf16(v0[2], v0[3]); w.z = cvt_pk_bf16(v1[0], v1[1]); w.w = cvt_pk_bf16(v1[2], v1[3]);
                    *(u32x4*)(rowp + bj * HALF) = w; } }
    }
};
template <int ACT  > struct EpiPlain {
    static constexpr bool PERM = true, AFTER_DRAIN = false;
    bf16_t* O; int ldc; int ncolt; int maxcol;
    __device__ __forceinline__ void operator()(const f32x4 (&acc)[2][2][4][2], const Unit& u, int wr, int wc, int fr, int fq) const {
        const int row0 = u.pm * BM + wr * 64 + fr; const int col0 = (u.pn % ncolt) * BM + wc * 32 + 8 * fq;
#pragma unroll
        for (int ai = 0; ai < 2; ++ai)
#pragma unroll
            for (int m = 0; m < 4; ++m) { bf16_t* rowp = O + (size_t)(row0 + ai * HALF + m * 16) * ldc + col0;
#pragma unroll
                for (int bj = 0; bj < 2; ++bj) { if (col0 + bj * HALF >= maxcol) continue;
                    f32x4 v0 = acc[ai][bj][m][0], v1 = acc[ai][bj][m][1];
                    if (ACT == 1) {
#pragma unroll
                        for (int i = 0; i < 4; ++i) { { const float x = v0[i]; const float t = 0.7978845608028654f * (x + 0.044715f * x * x * x); const float e = __expf(2.f * t); const float th = 1.f - 2.f / (e + 1.f); v0[i] = 0.5f * x * (1.f + th); }
                                                      { const float x = v1[i]; const float t = 0.7978845608028654f * (x + 0.044715f * x * x * x); const float e = __expf(2.f * t); const float th = 1.f - 2.f / (e + 1.f); v1[i] = 0.5f * x * (1.f + th); } } }
                    u32x4 w; w.x = cvt_pk_bf16(v0[0], v0[1]); w.y = cvt_pk_bf16(v0[2], v0[3]); w.z = cvt_pk_bf16(v1[0], v1[1]); w.w = cvt_pk_bf16(v1[2], v1[3]);
                    *(u32x4*)(rowp + bj * HALF) = w; } }
    }
};
struct EpiGate {
    static constexpr bool PERM = true, AFTER_DRAIN = false;
    const bf16_t* Y; const float* bg; bf16_t* MG;
    __device__ __forceinline__ void operator()(const f32x4 (&acc)[2][2][4][2], const Unit& u, int wr, int wc, int fr, int fq) const {
        const int row0 = u.pm * BM + wr * 64 + fr; const int e0 = u.pn * 64 + wc * 16 + fq * 4;
        f32x4 bv[4];
#pragma unroll
        for (int br = 0; br < 4; ++br) bv[br] = *(const f32x4*)(bg + br * DM + e0);
#pragma unroll
        for (int ai = 0; ai < 2; ++ai)
#pragma unroll
            for (int m = 0; m < 4; ++m) { const size_t ro = (size_t)(row0 + ai * HALF + m * 16) * DM + e0; f32x4 sum = {0.f, 0.f, 0.f, 0.f};
#pragma unroll
                for (int br = 0; br < 4; ++br) { const f32x4 a = acc[ai][br >> 1][m][br & 1] + bv[br];
                    const unsigned long long yv = *(const unsigned long long*)(Y + (size_t)br * S * DM + ro);
                    const unsigned ylo = (unsigned)yv, yhi = (unsigned)(yv >> 32);
                    f32x4 y; y[0] = __uint_as_float(ylo << 16); y[1] = __uint_as_float(ylo & 0xffff0000u); y[2] = __uint_as_float(yhi << 16); y[3] = __uint_as_float(yhi & 0xffff0000u);
#pragma unroll
                    for (int i = 0; i < 4; ++i) { const float g = 1.f / (1.f + __expf(-a[i])); sum[i] += g * y[i]; } }
                const unsigned long long o = (unsigned long long)cvt_pk_bf16(sum[0], sum[1]) | ((unsigned long long)cvt_pk_bf16(sum[2], sum[3]) << 32);
                *(unsigned long long*)(MG + ro) = o; }
    }
};
struct EpiRes {
    static constexpr bool PERM = false, AFTER_DRAIN = false;
    const float* base; float* out;
    __device__ __forceinline__ void operator()(const f32x4 (&acc)[2][2][4][2], const Unit& u, int wr, int wc, int fr, int fq) const {
        const int row0 = u.pm * BM + wr * 64 + fr; const int col0 = u.pn * BM + wc * 32 + 4 * fq;
#pragma unroll
        for (int ai = 0; ai < 2; ++ai)
#pragma unroll
            for (int m = 0; m < 4; ++m) { const size_t off = (size_t)(row0 + ai * HALF + m * 16) * DM + col0;
#pragma unroll
                for (int bj = 0; bj < 2; ++bj)
#pragma unroll
                    for (int n = 0; n < 2; ++n) { const f32x4 b = *(const f32x4*)(base + off + bj * HALF + n * 16); *(f32x4*)(out + off + bj * HALF + n * 16) = b + acc[ai][bj][m][n]; } }
    }
};
struct EpiSwiglu {
    static constexpr bool PERM = true, AFTER_DRAIN = false;
    bf16_t* ACT;
    __device__ __forceinline__ void operator()(const f32x4 (&acc)[2][2][4][2], const Unit& u, int wr, int wc, int fr, int fq) const {
        const int row0 = u.pm * BM + wr * 64 + fr; const int col0 = u.pn * HALF + wc * 32 + 8 * fq;
#pragma unroll
        for (int ai = 0; ai < 2; ++ai)
#pragma unroll
            for (int m = 0; m < 4; ++m) { f32x4 r0, r1;
#pragma unroll
                for (int i = 0; i < 4; ++i) { const float g0 = acc[ai][0][m][0][i], g1 = acc[ai][0][m][1][i];
                    r0[i] = g0 / (1.f + __expf(-g0)) * acc[ai][1][m][0][i]; r1[i] = g1 / (1.f + __expf(-g1)) * acc[ai][1][m][1][i]; }
                u32x4 w; w.x = cvt_pk_bf16(r0[0], r0[1]); w.y = cvt_pk_bf16(r0[2], r0[3]); w.z = cvt_pk_bf16(r1[0], r1[1]); w.w = cvt_pk_bf16(r1[2], r1[3]);
                *(u32x4*)(ACT + (size_t)(row0 + ai * HALF + m * 16) * NFF + col0) = w; }
    }
};
struct StackOrder {
    int nMb, nNb, nb, G, c;
    __device__ __forceinline__ void init(int nMb_, int nNb_, int nb_, int G_, int c_) { nMb = nMb_; nNb = nNb_; nb = nb_; G = G_; c = c_; }
    __device__ __forceinline__ bool next(int i, Unit& u) const {
        const long L = (long)i * G + c; const int per = nMb * nNb; if (L >= (long)per * nb) return false;
        const int b = (int)L / per, w = (int)L % per; u.pm = b * nMb + (w % nMb); u.pn = b * nNb + (w / nMb); u.ko = 0; return true;
    }
    __device__ __forceinline__ void a_ready(const Unit&) const {}
    __device__ __forceinline__ void done(const Unit&) const {}
};
struct SplitKOrder {
    int G, c;
    __device__ __forceinline__ void init(int G_, int c_) { G = G_; c = c_; }
    __device__ __forceinline__ bool next(int i, Unit& u) const { const int L = i * G + c; if (L >= 16) return false; u.pm = L & 3; u.pn = (L & 3) >> 1; u.ko = (L >> 2) * 1024; return true; }
    __device__ __forceinline__ void a_ready(const Unit&) const {}
    __device__ __forceinline__ void done(const Unit&) const {}
};
struct EpiPartial {
    static constexpr bool PERM = false, AFTER_DRAIN = false;
    float* O;
    __device__ __forceinline__ void operator()(const f32x4 (&acc)[2][2][4][2], const Unit& u, int wr, int wc, int fr, int fq) const {
        const int row0 = u.pm * BM + wr * 64 + fr; const int col0 = wc * 32 + 4 * fq; float* base = O + (size_t)(u.ko >> 10) * 1024 * 256;
#pragma unroll
        for (int ai = 0; ai < 2; ++ai)
#pragma unroll
            for (int m = 0; m < 4; ++m) { float* rowp = base + (size_t)(row0 + ai * HALF + m * 16) * 256 + col0;
#pragma unroll
                for (int bj = 0; bj < 2; ++bj)
#pragma unroll
                    for (int n = 0; n < 2; ++n) *(f32x4*)(rowp + bj * HALF + n * 16) = acc[ai][bj][m][n]; }
    }
};
}
#define GAS __attribute__((address_space(1)))
#define LAS __attribute__((address_space(3)))
typedef unsigned short bf16;
typedef unsigned v4u __attribute__((ext_vector_type(4)));
typedef unsigned v2u __attribute__((ext_vector_type(2)));
typedef float f32x4 __attribute__((ext_vector_type(4)));
typedef float f32x16 __attribute__((ext_vector_type(16)));
typedef short bf16x8 __attribute__((ext_vector_type(8)));
typedef short s16x4 __attribute__((ext_vector_type(4)));
typedef GAS unsigned gu32;
#define RLX_AGENT __ATOMIC_RELAXED, __HIP_MEMORY_SCOPE_AGENT
#define LDS_WAIT() asm volatile("s_waitcnt lgkmcnt(0)" ::: "memory")
#define VM_WAIT() asm volatile("s_waitcnt vmcnt(0)" ::: "memory")
__device__ __forceinline__ unsigned f2bf(float f) { unsigned u = __builtin_bit_cast(unsigned, f); return (u + 0x7fffu + ((u >> 16) & 1u)) >> 16; }
__device__ __forceinline__ unsigned pk2(float lo, float hi) { return f2bf(lo) | (f2bf(hi) << 16); }
__device__ __forceinline__ float bf2f(unsigned short b) { return __uint_as_float((unsigned)b << 16); }
__device__ __forceinline__ float bflo(unsigned w) { return __uint_as_float(w << 16); }
__device__ __forceinline__ float bfhi(unsigned w) { return __uint_as_float(w & 0xffff0000u); }
__device__ __forceinline__ unsigned cvtpk(float lo, float hi) { unsigned r; asm volatile("v_cvt_pk_bf16_f32 %0, %1, %2" : "=v"(r) : "v"(lo), "v"(hi)); return r; }
__device__ __forceinline__ float wave_sum(float v) {
#pragma unroll
    for (int o = 1; o < 64; o <<= 1) v += __shfl_xor(v, o);
    return v;
}
#define XB_TMO      128
#define XB_XCNT(j)  (256  + 64 * (j))
#define XB_XSUB(j)  (1280 + 64 * (j))
#define XB_XGEN(j)  (2304 + 64 * (j))
#define XB_TOP      3328
#define XB_TOPGEN   3392
#define XCD_BAR_WORDS 3456
#define XB_SPIN_CAP (1u << 18)

__device__ __forceinline__ unsigned xb_ld(unsigned* p)              { return __hip_atomic_load(p, __ATOMIC_RELAXED, __HIP_MEMORY_SCOPE_AGENT); }
__device__ __forceinline__ unsigned xb_add(unsigned* p, unsigned v) { return __hip_atomic_fetch_add(p, v, __ATOMIC_RELAXED, __HIP_MEMORY_SCOPE_AGENT); }
__device__ __forceinline__ unsigned xb_xcc_id() { return (unsigned)__builtin_amdgcn_s_getreg((3 << 11) | 20) & 0xFu; }
#define XB_SPIN(cond, bar) do { unsigned _sp = 0; while (cond) { __builtin_amdgcn_s_sleep(1); \
    if ((++_sp & 255u) == 0u) { if (xb_ld(&(bar)[XB_TMO])) break; if (_sp > XB_SPIN_CAP) { atomicAdd(&(bar)[XB_TMO], 1u); break; } } } } while (0)

struct XcdBarrier {
    unsigned* bar; unsigned x;
    volatile LAS unsigned* st;
};

__device__ __forceinline__ XcdBarrier xcd_barrier_post(unsigned* bar, volatile LAS unsigned* st) {
    XcdBarrier b; b.bar = bar; b.x = xb_xcc_id(); b.st = st;
    if (threadIdx.x == 0) (void)xb_add(&bar[XB_XCNT(b.x)], 1u);
    return b;
}
__device__ __forceinline__ void xcd_barrier_complete(unsigned* bar, unsigned x, unsigned& nloc, unsigned& nx) {
    const unsigned G = gridDim.x * gridDim.y * gridDim.z;
    unsigned sum, cnt, mine, sp = 0u;
    for (;;) {
        sum = 0u; cnt = 0u; mine = 0u;
#pragma unroll
        for (unsigned j = 0; j < 16; ++j) { const unsigned c = xb_ld(&bar[XB_XCNT(j)]); sum += c; cnt += (c > 0u) ? 1u : 0u; mine = (j == x) ? c : mine; }
        if (sum == G) break;
        __builtin_amdgcn_s_sleep(1);
        if ((++sp & 255u) == 0u) { if (xb_ld(&bar[XB_TMO])) break; if (sp > XB_SPIN_CAP) { atomicAdd(&bar[XB_TMO], 1u); break; } }
    }
    nloc = mine > 0u ? mine : 1u; nx = cnt > 0u ? cnt : 1u;
}

__device__ __forceinline__ void xcd_barrier(const XcdBarrier& b) {
    asm volatile("s_waitcnt vmcnt(0)" ::: "memory");
    __syncthreads();
    if (threadIdx.x == 0) {
        unsigned* bar = b.bar;
        __builtin_amdgcn_s_waitcnt(0);
        unsigned nloc = b.st[0], nx = b.st[1];
        if (nloc == 0u) { xcd_barrier_complete(bar, b.x, nloc, nx); b.st[0] = nloc; b.st[1] = nx; }
        const unsigned old = xb_add(&bar[XB_XSUB(b.x)], 1u);
        const unsigned gen = old / nloc;
        if (old + 1u == (gen + 1u) * nloc) {
            __builtin_amdgcn_fence(__ATOMIC_RELEASE, "agent");
            asm volatile("s_waitcnt vmcnt(0)" ::: "memory");
            const unsigned og = xb_add(&bar[XB_TOP], 1u);
            const unsigned tg = og / nx;
            if (og + 1u == (tg + 1u) * nx) xb_add(&bar[XB_TOPGEN], 1u);
            else XB_SPIN(xb_ld(&bar[XB_TOPGEN]) == tg, bar);
            __builtin_amdgcn_fence(__ATOMIC_ACQUIRE, "agent");
            xb_add(&bar[XB_XGEN(b.x)], 1u);
            asm volatile("s_waitcnt vmcnt(0)" ::: "memory");
        } else {
            XB_SPIN(xb_ld(&bar[XB_XGEN(b.x)]) == gen, bar);
            __builtin_amdgcn_fence(__ATOMIC_ACQUIRE, "agent");
            asm volatile("s_waitcnt vmcnt(0)" ::: "memory");
        }
    }
    __syncthreads();
}
namespace att {
constexpr float SCALE = 0.08838834764831845f, LOG2E = 1.4426950408889634f, LN2 = 0.6931471805599453f;
#define KSWZ(row, colB) ((row) * 256 + ((colB) ^ (((row) & 7) << 4)))
#define MFMA32(a, b, c) __builtin_amdgcn_mfma_f32_32x32x16_bf16((a), (b), (c), 0, 0, 0)
__device__ __forceinline__ int crow(int r, int hi) { return (r & 3) + 8 * (r >> 2) + 4 * hi; }
__device__ __forceinline__ int v_st(int k, int c) { const int kk = (k & ~0xC) | ((k & 4) << 1) | ((k & 8) >> 1); return ((kk >> 3) * 4 + (c >> 5)) * 512 + ((kk & 7) * 32 + (c & 31)) * 2; }
__device__ __forceinline__ int v_rd_base(int lane) { return ((lane & 3) << 3) | (((lane >> 2) & 3) << 6) | (((lane >> 4) & 1) << 5) | (((lane >> 5) & 1) << 8); }
__device__ __forceinline__ constexpr int v_rd_off(int d0, int ks, int half) { return d0 * 512 + ks * 4096 + half * 2048; }
typedef short v4i16_t __attribute__((ext_vector_type(4)));
__device__ __forceinline__ s16x4 tr_read(const LAS char* p) { return __builtin_bit_cast(s16x4, __builtin_amdgcn_ds_read_tr16_b64_v4i16((LAS v4i16_t*)p)); }
__device__ __forceinline__ float swap_max(float x) { auto rr = __builtin_amdgcn_permlane32_swap(__float_as_uint(x), __float_as_uint(x), false, false); return fmaxf(__uint_as_float(rr[0]), __uint_as_float(rr[1])); }
__device__ __forceinline__ float swap_add(float x) { auto rr = __builtin_amdgcn_permlane32_swap(__float_as_uint(x), __float_as_uint(x), false, false); return __uint_as_float(rr[0]) + __uint_as_float(rr[1]); }

__device__ __forceinline__ f32x16 zero16() { float z = 0.f; asm volatile("" : "+v"(z)); f32x16 r;
#pragma unroll
    for (int i = 0; i < 16; ++i) r[i] = z;
    return r; }
enum { M_A = 0, M_B = 1, M_C = 2, M_SLC = 3, M_WIN = 4, M_CMP = 5 };
constexpr int ATT_LDS_V = 0, ATT_LDS_K = 16384  , ATT_LDS_WS = 65536, ATT_LDS_CB = 65536 + 2048  , ATT_LDS_END = 65536 + 2048 + 512;

struct AttnP {
    const bf16* Q; const bf16* K; const bf16* V; bf16* O; float* LSE;
    const float* cum;
    const unsigned* bm;
    int q_pitch, kv_pitch, o_pitch, lse_pitch;
    int q_tok0, q_tstride, q_sub0;
    int k_tok0, k_tstride;
    int j_lo, j_hi;
};

template <int MODE, bool GQA>
__device__ __forceinline__ void attn_unit(const AttnP& p, LAS char* lds) {
    int tid_ = threadIdx.x; asm volatile("" : "+v"(tid_));
    const int tid = tid_, lane = tid & 63, r32 = lane & 31, hi = lane >> 5;
    const int wid = __builtin_amdgcn_readfirstlane(tid >> 6);
    constexpr int Q_PITCH = NP, O_PITCH = 512, LSE_PITCH = 4, KV_PITCH = (MODE == M_CMP) ? 128 : NP;
    const int q_tstride = (MODE == M_A) ? p.q_tstride : 1, k_tok0 = (MODE == M_A) ? p.k_tok0 : 0, k_tstride = (MODE == M_A) ? p.k_tstride : 1, q_sub0 = (MODE == M_A) ? p.q_sub0 : p.q_tok0;
    LAS float* wsc = (LAS float*)(lds + ATT_LDS_WS) + wid * 64;
    LAS float* cb = (LAS float*)(lds + ATT_LDS_CB);
    const int rowbase = GQA ? (wid >> 2) * 32 : wid * 32;
    const int rho = rowbase + r32;
    const int hcol = GQA ? (wid & 3) * 128 : 0;
    const int qtok = p.q_tok0 + rho * q_tstride;
    const int qsub = q_sub0 + rho;
    const int qmin = q_sub0 + rowbase, qmax = qmin + 31;
    constexpr float CEXP = (MODE == M_B) ? LOG2E : SCALE * LOG2E;
    bf16x8 qr[8];
    { const bf16* Qw = p.Q + (size_t)qtok * Q_PITCH + hcol + hi * 8;
#pragma unroll
      for (int d0 = 0; d0 < 8; ++d0) qr[d0] = *(const bf16x8*)(Qw + d0 * 16); }
    float m_reg = -1e30f, l_reg = 0.f; f32x16 o[4];
#pragma unroll
    for (int d = 0; d < 4; ++d) o[d] = zero16();
    const int sr = tid >> 4, sc = (tid & 15) * 8;
    const int vst0 = v_st(sr, sc), vst1 = v_st(32 + sr, sc), kst0 = KSWZ(sr, sc * 2), kst1 = KSWZ(32 + sr, sc * 2);
    const int vrb = v_rd_base(lane);
    struct Stage { bf16x8 vs0, vs1, ks0, ks1; float cpre; unsigned long long bmw; }; Stage sA, sB; sA.cpre = 0.f; sB.cpre = 0.f; sA.bmw = 0ull; sB.bmw = 0ull; unsigned long long bmw = 0ull;
    unsigned sel0 = 0u, sel1 = 0u, sel2 = 0u, sel3 = 0u; float cref = 0.f;
    if (MODE == M_SLC) { const v4u s4 = *(const v4u*)(p.bm + (size_t)qtok * 4); sel0 = s4.x; sel1 = s4.y; sel2 = s4.z; sel3 = s4.w; }
    if (MODE == M_B) cref = p.cum[p.q_tok0];
#define ATT_LOADT(ST, j) do { const int kk0_ = 64 * (j) + sr; const size_t t0_ = (size_t)(k_tok0 + kk0_ * k_tstride) * KV_PITCH + sc, t1_ = (size_t)(k_tok0 + (kk0_ + 32) * k_tstride) * KV_PITCH + sc; \
        ST.ks0 = *(const bf16x8*)(p.K + t0_); ST.ks1 = *(const bf16x8*)(p.K + t1_); ST.vs0 = *(const bf16x8*)(p.V + t0_); ST.vs1 = *(const bf16x8*)(p.V + t1_); \
        if (MODE == M_B) { if (tid < 64) ST.cpre = cref - p.cum[64 * (j) + tid]; } \
        if (MODE == M_C) ST.bmw = *(const unsigned long long*)(p.bm + (size_t)qtok * 256 + 2 * (j)); } while (0)
#define ATT_WRITET(ST, buf) do { LAS char* vl_ = lds + (buf) * 32768 + ATT_LDS_V; LAS char* kl_ = lds + (buf) * 32768 + ATT_LDS_K; \
        *(LAS bf16x8*)(vl_ + vst0) = ST.vs0; *(LAS bf16x8*)(vl_ + vst1) = ST.vs1; *(LAS bf16x8*)(kl_ + kst0) = ST.ks0; *(LAS bf16x8*)(kl_ + kst1) = ST.ks1; \
        if (MODE == M_B) { if (tid < 64) cb[(buf) * 64 + tid] = ST.cpre; } \
        if (MODE == M_C) bmw = ST.bmw; } while (0)
    if (p.j_lo < p.j_hi) {
        ATT_LOADT(sA, p.j_lo);
        __syncthreads();
        ATT_WRITET(sA, 0);
        if (p.j_lo + 1 < p.j_hi) ATT_LOADT(sA, p.j_lo + 1);
        if (p.j_lo + 2 < p.j_hi) ATT_LOADT(sB, p.j_lo + 2);
        __syncthreads();
        for (int j0 = p.j_lo; j0 < p.j_hi; j0 += 2)
#pragma unroll
        for (int half = 0; half < 2; ++half) { const int j = j0 + half; const int buf = half; if (j >= p.j_hi) break;
            const LAS char* K_lds = lds + buf * 32768 + ATT_LDS_K; const LAS char* vb0 = lds + buf * 32768 + ATT_LDS_V + vrb;
            f32x16 p0, p1;
#pragma unroll
            for (int d0 = 0; d0 < 8; ++d0) { const int cbt = (d0 * 16 + hi * 8) * 2;
                const bf16x8 b0 = *(const LAS bf16x8*)(K_lds + KSWZ(r32, cbt)); const bf16x8 b1 = *(const LAS bf16x8*)(K_lds + KSWZ(32 + r32, cbt));
                if (d0 == 0) { const f32x16 z16 = {0.f, 0.f, 0.f, 0.f, 0.f, 0.f, 0.f, 0.f, 0.f, 0.f, 0.f, 0.f, 0.f, 0.f, 0.f, 0.f}; p0 = MFMA32(b0, qr[0], z16); p1 = MFMA32(b1, qr[0], z16); }
                else { p0 = MFMA32(b0, qr[d0], p0); p1 = MFMA32(b1, qr[d0], p1); } }
            {
                const float NINF = -__builtin_inff();
                bool interior;
                if (MODE == M_A)        interior = 64 * j + 63 <= qmin && qmax - 64 * j <= 128;
                else if (MODE == M_B)   interior = 64 * j + 63 <= qmin;
                else if (MODE == M_SLC) interior = 64 * j + 63 <= qmin;
                else if (MODE == M_WIN) interior = 64 * j + 63 <= qmin && qmax - 64 * j < 512;
                else if (MODE == M_CMP) interior = 16 * (64 * j + 63) + 31 <= qmin;
                else                    interior = false;
                bool selb = true;
                if (MODE == M_SLC) { const unsigned sw = j < 32 ? sel0 : (j < 64 ? sel1 : (j < 96 ? sel2 : sel3)); selb = ((sw >> (j & 31)) & 1u) != 0u; }
                if (interior) {
                    if (MODE == M_B) {
#pragma unroll
                        for (int g = 0; g < 4; ++g) { const f32x4 bia0 = *(const LAS f32x4*)(cb + buf * 64 + 8 * g + 4 * hi), bia1 = *(const LAS f32x4*)(cb + buf * 64 + 32 + 8 * g + 4 * hi);
#pragma unroll
                            for (int i = 0; i < 4; ++i) { p0[4 * g + i] = fmaf(p0[4 * g + i], SCALE, bia0[i]); p1[4 * g + i] = fmaf(p1[4 * g + i], SCALE, bia1[i]); } }
                    } else if (MODE == M_SLC) {
#pragma unroll
                        for (int r = 0; r < 16; ++r) { p0[r] = selb ? p0[r] : NINF; p1[r] = selb ? p1[r] : NINF; }
                    }
                } else {
                    int dq = qsub - 64 * j - 4 * hi;
                    asm volatile("" : "+v"(dq));
                    int lim = 0; unsigned w0 = 0u, w1 = 0u;
                    if (MODE == M_CMP) { lim = ((qsub - 31) >> 4) - 64 * j - 4 * hi; asm volatile("" : "+v"(lim)); }
                    if (MODE == M_C) { w0 = (unsigned)bmw >> (4 * hi); w1 = (unsigned)(bmw >> 32) >> (4 * hi); }
#pragma unroll
                    for (int g = 0; g < 4; ++g) {
                        f32x4 bia0 = {0.f, 0.f, 0.f, 0.f}, bia1 = {0.f, 0.f, 0.f, 0.f};
                        if (MODE == M_B) { bia0 = *(const LAS f32x4*)(cb + buf * 64 + 8 * g + 4 * hi); bia1 = *(const LAS f32x4*)(cb + buf * 64 + 32 + 8 * g + 4 * hi); }
#pragma unroll
                        for (int i = 0; i < 4; ++i) { const int r = 4 * g + i, base = i + 8 * g;
                            bool v0, v1;
                            if (MODE == M_A)        { v0 = (unsigned)(dq - base) <= 128u; v1 = (unsigned)(dq - base - 32) <= 128u; }
                            else if (MODE == M_B)   { v0 = base <= dq; v1 = base + 32 <= dq; }
                            else if (MODE == M_C)   { v0 = ((w0 >> base) & 1u) != 0u; v1 = ((w1 >> base) & 1u) != 0u; }
                            else if (MODE == M_SLC) { v0 = selb && base <= dq; v1 = selb && base + 32 <= dq; }
                            else if (MODE == M_WIN) { v0 = (unsigned)(dq - base) < 512u; v1 = (unsigned)(dq - base - 32) < 512u; }
                            else                    { v0 = base <= lim; v1 = base + 32 <= lim; }
                            if (MODE == M_B) { p0[r] = v0 ? fmaf(p0[r], SCALE, bia0[i]) : NINF; p1[r] = v1 ? fmaf(p1[r], SCALE, bia1[i]) : NINF; }
                            else             { p0[r] = v0 ? p0[r] : NINF; p1[r] = v1 ? p1[r] : NINF; } }
                    }
                }
            }
            float pmax = p0[0];
#pragma unroll
            for (int r = 1; r < 16; ++r) pmax = fmaxf(pmax, p0[r]);
#pragma unroll
            for (int r = 0; r < 16; ++r) pmax = fmaxf(pmax, p1[r]);
            pmax = swap_max(pmax);
            const float mn = fmaxf(m_reg, pmax); const float alpha = __builtin_amdgcn_exp2f((m_reg - mn) * CEXP); m_reg = mn;
            const float mnC = -mn * CEXP;
#pragma unroll
            for (int r = 0; r < 16; ++r) { p0[r] = __builtin_amdgcn_exp2f(fmaf(p0[r], CEXP, mnC)); p1[r] = __builtin_amdgcn_exp2f(fmaf(p1[r], CEXP, mnC)); }
            float ps = 0.f;
#pragma unroll
            for (int r = 0; r < 16; ++r) ps += p0[r] + p1[r];
            ps = swap_add(ps);
            l_reg = l_reg * alpha + ps;
            if (__any(alpha < 1.f)) {
                if (hi == 0) wsc[r32] = alpha;
                LDS_WAIT();
#pragma unroll
                for (int r = 0; r < 16; ++r) { const float a = wsc[crow(r, hi)];
#pragma unroll
                    for (int d = 0; d < 4; ++d) o[d][r] *= a; }
            }
            bf16x8 pa0, pa1, pa2, pa3;
#define ATT_PK4(P, BASE, OUT) do { unsigned a0 = cvtpk(P[BASE + 0], P[BASE + 1]), a1 = cvtpk(P[BASE + 2], P[BASE + 3]); \
                unsigned b0_ = cvtpk(P[BASE + 4], P[BASE + 5]), b1_ = cvtpk(P[BASE + 6], P[BASE + 7]); \
                auto r0 = __builtin_amdgcn_permlane32_swap(a0, b0_, false, false); auto r1 = __builtin_amdgcn_permlane32_swap(a1, b1_, false, false); \
                v4u w = {r0[0], r1[0], r0[1], r1[1]}; OUT = __builtin_bit_cast(bf16x8, w); } while (0)
            ATT_PK4(p0, 0, pa0); ATT_PK4(p0, 8, pa1); ATT_PK4(p1, 0, pa2); ATT_PK4(p1, 8, pa3);
#define ATT_PKV(L, H) (bf16x8){L[0], L[1], L[2], L[3], H[0], H[1], H[2], H[3]}
#pragma unroll
            for (int d0 = 0; d0 < 4; ++d0) {
                const s16x4 l0 = tr_read(vb0 + v_rd_off(d0, 0, 0)), h0 = tr_read(vb0 + v_rd_off(d0, 0, 1)), l1 = tr_read(vb0 + v_rd_off(d0, 1, 0)), h1 = tr_read(vb0 + v_rd_off(d0, 1, 1));
                const s16x4 l2 = tr_read(vb0 + v_rd_off(d0, 2, 0)), h2 = tr_read(vb0 + v_rd_off(d0, 2, 1)), l3 = tr_read(vb0 + v_rd_off(d0, 3, 0)), h3 = tr_read(vb0 + v_rd_off(d0, 3, 1));
                o[d0] = MFMA32(pa0, ATT_PKV(l0, h0), o[d0]); o[d0] = MFMA32(pa1, ATT_PKV(l1, h1), o[d0]);
                o[d0] = MFMA32(pa2, ATT_PKV(l2, h2), o[d0]); o[d0] = MFMA32(pa3, ATT_PKV(l3, h3), o[d0]);
            }
            if (half == 0) { if (j + 1 < p.j_hi) { ATT_WRITET(sA, 1); } __syncthreads(); if (j + 3 < p.j_hi) ATT_LOADT(sA, j + 3); }
            else           { if (j + 1 < p.j_hi) { ATT_WRITET(sB, 0); } __syncthreads(); if (j + 3 < p.j_hi) ATT_LOADT(sB, j + 3); }
        }
    }
#undef ATT_LOADT
#undef ATT_WRITET
    if (hi == 0) wsc[32 + r32] = l_reg;
    if (p.LSE != nullptr && hi == 0) p.LSE[(size_t)qtok * LSE_PITCH + (GQA ? (wid & 3) : 0)] = l_reg > 0.f ? m_reg * (MODE == M_B ? 1.f : SCALE) + __builtin_amdgcn_logf(l_reg) * LN2 : -1e30f;
    LDS_WAIT();
#pragma unroll
    for (int r = 0; r < 16; ++r) { const int rr = crow(r, hi); const float lv = wsc[32 + rr]; const float rl = lv > 0.f ? 1.f / lv : 0.f;
        bf16* orow = p.O + (size_t)(p.q_tok0 + (rowbase + rr) * q_tstride) * O_PITCH + hcol + r32;
#pragma unroll
        for (int d0 = 0; d0 < 4; ++d0) orow[d0 * 32] = (bf16)f2bf(o[d0][r] * rl); }
}

__device__ __forceinline__ void idx_unit(const bf16* P, float* SC, int qb, int kc, LAS char* lds, unsigned long long* tsx = nullptr) {
    int tid_ = threadIdx.x; asm volatile("" : "+v"(tid_));
    const int tid = tid_, lane = tid & 63, r32 = lane & 31, hi = lane >> 5;
    const int wid = __builtin_amdgcn_readfirstlane(tid >> 6);
    bf16x8 kf[4][4];
    { const bf16* kp = P + (size_t)(128 * kc + r32) * NP + COL_MISC + MI_CKI + hi * 8;
#pragma unroll
      for (int s = 0; s < 4; ++s)
#pragma unroll
          for (int ks = 0; ks < 4; ++ks) kf[s][ks] = *(const bf16x8*)(kp + (size_t)(32 * s) * NP + ks * 16); }
    unsigned long long tA_ = 0, tB_ = 0; if (tsx) { asm volatile("s_waitcnt vmcnt(0)" ::: "memory"); tA_ = __builtin_amdgcn_s_memrealtime(); }
    const int t = 256 * qb + wid * 32 + r32;
    f32x16 acc[4];
#pragma unroll
    for (int s = 0; s < 4; ++s) acc[s] = zero16();
    const bf16* qrow = P + (size_t)t * NP + COL_CQI + hi * 8;
    const bf16* wrow = P + (size_t)t * NP + COL_MISC + MI_CWI;
#pragma unroll 1
    for (int g = 0; g < 4; ++g) {
        bf16x8 qg[4][4];
#pragma unroll
        for (int hh = 0; hh < 4; ++hh) {
#pragma unroll
            for (int ks = 0; ks < 4; ++ks) qg[hh][ks] = *(const bf16x8*)(qrow + (4 * g + hh) * 64 + ks * 16); }
        const v2u wpk = *(const v2u*)(wrow + 4 * g);
#pragma unroll
        for (int hh = 0; hh < 4; ++hh) {
#pragma unroll
            for (int sp = 0; sp < 2; ++sp) {
                const f32x16 z16 = {0.f, 0.f, 0.f, 0.f, 0.f, 0.f, 0.f, 0.f, 0.f, 0.f, 0.f, 0.f, 0.f, 0.f, 0.f, 0.f};
                f32x16 pa = MFMA32(kf[2 * sp][0], qg[hh][0], z16), pb = MFMA32(kf[2 * sp + 1][0], qg[hh][0], z16);
#pragma unroll
                for (int ks = 1; ks < 4; ++ks) { pa = MFMA32(kf[2 * sp][ks], qg[hh][ks], pa); pb = MFMA32(kf[2 * sp + 1][ks], qg[hh][ks], pb); }
                typedef float f32x2_ __attribute__((ext_vector_type(2)));
                const unsigned wbits = hh < 2 ? wpk.x : wpk.y; const float wh = ((hh & 1) ? bfhi(wbits) : bflo(wbits)) * 0.03125f;
                const f32x2_ w2 = {wh, wh};
#pragma unroll
                for (int r = 0; r < 16; r += 2) {
                    const f32x2_ ra = {__builtin_amdgcn_fmed3f(pa[r], 0.f, __builtin_inff()), __builtin_amdgcn_fmed3f(pa[r + 1], 0.f, __builtin_inff())};
                    const f32x2_ rb = {__builtin_amdgcn_fmed3f(pb[r], 0.f, __builtin_inff()), __builtin_amdgcn_fmed3f(pb[r + 1], 0.f, __builtin_inff())};
                    const f32x2_ a2 = {acc[2 * sp][r], acc[2 * sp][r + 1]}, b2 = {acc[2 * sp + 1][r], acc[2 * sp + 1][r + 1]};
                    const f32x2_ oa = __builtin_elementwise_fma(w2, ra, a2), ob = __builtin_elementwise_fma(w2, rb, b2);
                    acc[2 * sp][r] = oa[0]; acc[2 * sp][r + 1] = oa[1]; acc[2 * sp + 1][r] = ob[0]; acc[2 * sp + 1][r + 1] = ob[1]; }
#ifndef IDX_NOSB
                __builtin_amdgcn_sched_barrier(0);
#endif
            }
        }
    }
    if (tsx) { tB_ = __builtin_amdgcn_s_memrealtime(); }
    LAS float* img = (LAS float*)(lds + wid * 16384);
#pragma unroll
    for (int s = 0; s < 4; ++s)
#pragma unroll
        for (int g = 0; g < 4; ++g) { const f32x4 v = {acc[s][4 * g], acc[s][4 * g + 1], acc[s][4 * g + 2], acc[s][4 * g + 3]}; *(LAS f32x4*)(img + r32 * 128 + 4 * ((8 * s + 2 * g + hi) ^ r32)) = v; }
    LDS_WAIT();
    const int pitch = 256 * (qb + 1) + 32;
    float* out = SC + (size_t)65536 * (qb * (qb + 1) / 2) + (size_t)8192 * qb + (size_t)(wid * 32) * pitch + 128 * kc;
#pragma unroll
    for (int i = 0; i < 16; ++i) { const int row = 2 * i + (lane >> 5), c4 = (lane & 31) * 4; const f32x4 v = *(const LAS f32x4*)(img + row * 128 + 4 * ((lane & 31) ^ row)); *(f32x4*)(out + (size_t)row * pitch + c4) = v; }
    if (tsx) { asm volatile("s_waitcnt vmcnt(0)" ::: "memory"); const unsigned long long tC_ = __builtin_amdgcn_s_memrealtime(); if (threadIdx.x == 0) { tsx[0] += tB_ - tA_; tsx[1] += tC_ - tB_; tsx[2] += 1ull; } }
}

__device__ __forceinline__ unsigned satsub(unsigned a, unsigned b) { unsigned r; asm("v_sub_u32_e64 %0, %1, %2 clamp" : "=v"(r) : "v"(a), "v"(b)); return r; }
__device__ __forceinline__ int wave_isum(int v) {
#pragma unroll
    for (int o = 1; o < 64; o <<= 1) v += __shfl_xor(v, o);
    return v;
}
template <int NCH> __device__ __forceinline__ int count_ge(const unsigned (&key)[NCH], unsigned cand) {
    int cnt = 0;
#pragma unroll
    for (int i = 0; i < NCH; i += 8) {
        unsigned long long m0, m1, m2, m3, m4, m5, m6, m7;
        asm volatile("v_cmp_ge_u32_e64 %0, %8, %16\n\tv_cmp_ge_u32_e64 %1, %9, %16\n\tv_cmp_ge_u32_e64 %2, %10, %16\n\tv_cmp_ge_u32_e64 %3, %11, %16\n\t"
                     "v_cmp_ge_u32_e64 %4, %12, %16\n\tv_cmp_ge_u32_e64 %5, %13, %16\n\tv_cmp_ge_u32_e64 %6, %14, %16\n\tv_cmp_ge_u32_e64 %7, %15, %16\n\ts_nop 1"
                     : "=s"(m0), "=s"(m1), "=s"(m2), "=s"(m3), "=s"(m4), "=s"(m5), "=s"(m6), "=s"(m7)
                     : "v"(key[i]), "v"(key[i + 1]), "v"(key[i + 2]), "v"(key[i + 3]), "v"(key[i + 4]), "v"(key[i + 5]), "v"(key[i + 6]), "v"(key[i + 7]), "v"(cand));
        cnt += __builtin_popcountll(m0) + __builtin_popcountll(m1) + __builtin_popcountll(m2) + __builtin_popcountll(m3)
             + __builtin_popcountll(m4) + __builtin_popcountll(m5) + __builtin_popcountll(m6) + __builtin_popcountll(m7);
    }
    return cnt;
}
#define WRL(dst, sval, ln) asm volatile("s_nop 3\n\tv_writelane_b32 %0, %1, %2\n\ts_nop 1" : "+v"(dst) : "s"(sval), "n"(ln))
template <int NCH>
__device__ __forceinline__ void select_row(const float* SC, unsigned* BM, int t, int lane_) {
    int lane = lane_; asm volatile("" : "+v"(lane));
    const int qb_ = t >> 8; const float* row = SC + (size_t)65536 * (qb_ * (qb_ + 1) / 2) + (size_t)8192 * qb_ + (size_t)(t & 255) * (256 * (qb_ + 1) + 32);
    unsigned key[NCH]; constexpr int SELB = NCH < 64 ? NCH : 64;
#pragma unroll
    for (int b = 0; b < NCH; b += SELB) {
#pragma unroll
        for (int i = b; i < b + SELB; ++i) key[i] = __float_as_uint(row[i * 64 + lane]);
#pragma unroll
        for (int i = b; i < b + SELB; ++i) { unsigned u = key[i]; u ^= ((unsigned)((int)u >> 31) | 0x80000000u); key[i] = (i * 64 + lane) <= t ? u : 0u; }
        asm volatile("" ::: "memory");
    }
    unsigned prefix = 1u; int cge = t + 1;
    if (t >= 256) {
        prefix = 0u;
#pragma unroll 1
        for (int bit = 31; bit >= 0; --bit) {
            const unsigned cand = prefix | (1u << bit); const int c = count_ge<NCH>(key, cand);
            if (c >= 256) { prefix = cand; cge = c; }
            if (c == 256) break;
        }
    }
    const int target = t >= 256 ? 256 : t + 1;
    unsigned m0l = 0u, m0h = 0u, m1l = 0u, m1h = 0u;
    if (cge == target) {
#pragma unroll
        for (int i = 0; i < NCH; ++i) { const unsigned long long b = __ballot(key[i] >= prefix);
            if (i < 64) { WRL(m0l, (unsigned)b, i & 63); WRL(m0h, (unsigned)(b >> 32), i & 63); }
            else { WRL(m1l, (unsigned)b, i & 63); WRL(m1h, (unsigned)(b >> 32), i & 63); }
            __builtin_amdgcn_sched_barrier(0); }
    } else {
        int cgt = 0;
#pragma unroll
        for (int i = 0; i < NCH; ++i) cgt += (int)min(satsub(key[i], prefix), 1u);
        cgt = wave_isum(cgt);
        const int need = target - cgt; int run = 0; const unsigned long long lt = (1ull << lane) - 1ull;
#pragma unroll
        for (int i = 0; i < NCH; ++i) {
            const bool eq = key[i] == prefix; const unsigned long long beq = __ballot(eq);
            const bool selk = key[i] > prefix || (eq && (run + (int)__popcll(beq & lt)) < need);
            run += (int)__popcll(beq);
            const unsigned long long b = __ballot(selk);
            if (i < 64) { WRL(m0l, (unsigned)b, i & 63); WRL(m0h, (unsigned)(b >> 32), i & 63); }
            else { WRL(m1l, (unsigned)b, i & 63); WRL(m1h, (unsigned)(b >> 32), i & 63); }
            __builtin_amdgcn_sched_barrier(0);
        }
    }
    const int nwords = 8 * ((t >> 8) + 1);
    unsigned* brow = BM + (size_t)t * 256;
    if (2 * lane < nwords && lane < NCH) { const v2u o = {m0l, m0h}; *(v2u*)(brow + 2 * lane) = o; }
    if (NCH > 64) { if (128 + 2 * lane < nwords) { const v2u o = {m1l, m1h}; *(v2u*)(brow + 128 + 2 * lane) = o; } }
}
}
__device__ __forceinline__ int next_unit(unsigned* ctr, LAS char* lds) {
    LAS int* slot = (LAS int*)(lds + 131072);
    __syncthreads();
    if (threadIdx.x == 0) *slot = (int)__hip_atomic_fetch_add(ctr, 1u, __ATOMIC_RELAXED, __HIP_MEMORY_SCOPE_AGENT);
    __syncthreads();
    return *slot;
}
namespace att {
__device__ __forceinline__ int b_skip(const float* cum, int t0, int nt, const float* q2p, const float* k2p, int nwv, LAS char* lds) {
    LAS int* slot = (LAS int*)(lds + 131072 + 16);
    int tid = threadIdx.x; asm volatile("" : "+v"(tid));
    if (tid < 64) { float k2 = 0.f;
#pragma unroll
        for (int i = 0; i < 32; ++i) { const int wv = i * 64 + tid; if (wv < nwv) k2 = fmaxf(k2, k2p[wv]); }
#pragma unroll
        for (int o = 1; o < 64; o <<= 1) k2 = fmaxf(k2, __shfl_xor(k2, o));
        float q2 = fmaxf(fmaxf(q2p[tid], q2p[64 + tid]), fmaxf(q2p[128 + tid], q2p[192 + tid]));
#pragma unroll
        for (int o = 1; o < 64; o <<= 1) q2 = fmaxf(q2, __shfl_xor(q2, o));
        const float bound = 2.f * SCALE * sqrtf(q2) * sqrtf(k2) + 32.f;
        const float c0 = cum[t0]; const int j0 = tid, j1 = tid + 64;
        const bool ok0 = j0 < nt && (cum[64 * j0 + 63] - c0) <= bound, ok1 = j1 < nt && (cum[64 * j1 + 63] - c0) <= bound;
        const unsigned long long m0 = __ballot(ok0), m1 = __ballot(ok1);
        const int r = m0 ? (int)__builtin_ctzll(m0) : (m1 ? 64 + (int)__builtin_ctzll(m1) : nt);
        if (tid == 0) *slot = r; }
    __syncthreads();
    return *slot;
}
__device__ __forceinline__ void write_empty_lse(float* LSE, int t0, int pitch) { const int tid = threadIdx.x; if (tid < 256) LSE[(size_t)(t0 + tid) * pitch] = -1e30f; }
}
constexpr size_t MiB = 1u << 20;
constexpr size_t WS_CTL = 0, CTL_ZERO_BYTES = 1 * MiB;
constexpr size_t WS_TAB = 1 * MiB, WS_TABI = 5 * MiB, WS_OVM = 7 * MiB, WS_KI = 8 * MiB, WS_CUM = 9 * MiB, WS_NRM = 9 * MiB + 128 * 1024  , WS_KVC = 9 * MiB + 512 * 1024, WS_HID = 10 * MiB, WS_SEL = 11 * MiB;
constexpr size_t WS_LSEA = 12 * MiB, WS_LSEB = 12 * MiB + 512 * 1024, WS_LSEC = 13 * MiB + 128 * 1024, WS_LSES = 35 * MiB;
constexpr size_t WS_CA = 14 * MiB, WS_BM = 22 * MiB, WS_W2T = 30 * MiB, WS_W1T = 31 * MiB, WS_HIDP = 36 * MiB  , WS_XN = 40 * MiB, WS_X2 = 72 * MiB;
constexpr size_t WS_RA = 136 * MiB, WS_P = WS_RA, WS_Y = WS_RA, WS_WFI = WS_RA, WS_WFO = WS_RA + 44 * MiB;
constexpr size_t WS_RB = 296 * MiB, WS_OA = WS_RB, WS_PB = WS_OA + 24 * MiB, WS_PC = WS_PB + 36 * MiB, WS_PS = WS_PC + 36 * MiB, WS_OCMP = WS_PS + 36 * MiB, WS_OWIN = WS_OCMP + 8 * MiB, WS_IMPH = WS_OWIN + 8 * MiB;
constexpr size_t WS_MG = WS_RB, WS_ACT = WS_RB + 32 * MiB;
constexpr size_t WS_RC = 456 * MiB, WS_WIN = WS_RC, WS_SC = WS_RC, WS_WG = WS_RC, WS_WB = WS_RC + 32 * MiB, WS_WO = WS_RC + 40 * MiB;
constexpr size_t WS_BR = WS_RC + 64 * MiB, WS_END = 589 * MiB;
static_assert(WS_IMPH + 8 * MiB <= WS_RC && WS_ACT + 88 * MiB <= WS_RC && WS_WFO + 22 * MiB <= WS_RB, "ws map");
constexpr int CW_BAR = 4096, CW_QUEUE = 8192, CW_NORM = 12288;
constexpr int RING_BYTES = 131072, LDSCTL_OFF = RING_BYTES, MISC_OFF = LDSCTL_OFF + 320, LDS_BYTES = 147456;
constexpr int NWAVES = 8;
struct Frame { LAS unsigned char* lds; int tid, lane, wave, G, gw, NGW; };
__device__ __forceinline__ void mkframe(Frame& F, unsigned char* lds_raw, int grid) { int t = threadIdx.x; asm volatile("" : "+v"(t)); F.lds = (LAS unsigned char*)lds_raw; F.tid = t; F.lane = t & 63; F.wave = __builtin_amdgcn_readfirstlane(t >> 6);
    F.G = grid; F.gw = blockIdx.x * NWAVES + F.wave; F.NGW = F.G * NWAVES; }
enum { MAP_ID = 0, MAP_IN = 1, MAP_GATE = 2, MAP_FFI = 3, MAP_W2 = 4, MAP_W2P = 5 };
template <int MAP> __device__ __forceinline__ int src_col(int n) {
    if (MAP == MAP_IN) {
        const int p7 = n & 127, d128 = 4 * (p7 >> 3) + ((p7 >> 1) & 3) + 64 * (p7 & 1), hb = n & ~127;
        const int p6 = n & 63, d64 = 4 * (p6 >> 3) + ((p6 >> 1) & 3) + 32 * (p6 & 1), hb64 = n & ~63;
        if (n < 3072) return hb + d128;
        if (n < 6144) return n;
        if (n < 7168) return hb + 4 + d128;
        if (n < 7680) return n + 4;
        if (n < 8704) return hb64 + 4 + d64;
        if (n < 9216) return hb + 84 + d128;
        if (n < 9984) return (((n - 9216) >> 7) & 1) ? n + 84 : hb + 84 + d128;
        if (n < 10048) return 8708 + d64;
        if (n < 10052) return 6144 + (n - 10048);
        if (n < 10068) return 8772 + (n - 10052);
        if (n < 10080) return n;
        return -1;
    } else if (MAP == MAP_GATE) {
        const int pn = n >> 8, c = n & 255, bj = c >> 7, wc = (c >> 5) & 3, fq = (c >> 3) & 3, nn = (c >> 2) & 1, i = c & 3;
        return (2 * bj + nn) * DM + 64 * pn + 16 * wc + 4 * fq + i;
    } else if (MAP == MAP_FFI) {
        const int pn = n >> 8, c = n & 255; return ((c >> 7) ? NFF : 0) + 128 * pn + (c & 127);
    } else if (MAP == MAP_W2) {
        return n < 128 ? n : -1;
    } else if (MAP == MAP_W2P) {
        return n < 128 ? 4 * (n >> 3) + ((n >> 1) & 3) + 64 * (n & 1) : -1;
    } else return n;
}
template <int MAP> __device__ __forceinline__ void transpose_item(const float* W, int K, int Nsrc, int Ndst, bf16* WT, LAS float* scr, int item, int lane) {
    const int nblk = Ndst / 32, kb = item / nblk, nb = item % nblk, k0 = 64 * kb, n0 = 32 * nb;
    const int sc = src_col<MAP>(n0 + (lane & 31));
    float v[32];
    const float* wp = W + (size_t)(k0 + (lane >> 5)) * Nsrc + (sc >= 0 ? sc : 0);
#pragma unroll
    for (int i = 0; i < 32; ++i) v[i] = __builtin_nontemporal_load(wp + (size_t)(2 * i) * Nsrc);
#pragma unroll
    for (int i = 0; i < 32; ++i) scr[(2 * i + (lane >> 5)) * 33 + (lane & 31)] = sc >= 0 ? v[i] : 0.f;
    LDS_WAIT(); asm volatile("" ::: "memory");
    const int c = lane & 7;
#pragma unroll
    for (int j = 0; j < 4; ++j) { const int n = (lane >> 3) + 8 * j; const LAS float* s = scr + (8 * c) * 33 + n;
        v4u o; o.x = pk2(s[0 * 33], s[1 * 33]); o.y = pk2(s[2 * 33], s[3 * 33]); o.z = pk2(s[4 * 33], s[5 * 33]); o.w = pk2(s[6 * 33], s[7 * 33]);
        *(v4u*)(WT + (size_t)(n0 + n) * K + k0 + 8 * c) = o; }
    LDS_WAIT(); asm volatile("" ::: "memory");
}
template <int MAP> __device__ __forceinline__ void transpose_all(const Frame& F, const float* W, int K, int Nsrc, int Ndst, bf16* WT) {
    LAS float* scr = (LAS float*)(F.lds + F.wave * 16384);
    const int nitems = (K / 64) * (Ndst / 32);
    for (int it = F.gw; it < nitems; it += F.NGW) transpose_item<MAP>(W, K, Nsrc, Ndst, WT, scr, it, F.lane);
}
template <int MAP> __device__ __forceinline__ void transpose_some(const Frame& F, int gw, int ngw, const float* W, int K, int Nsrc, int Ndst, bf16* WT) {
    LAS float* scr = (LAS float*)(F.lds + F.wave * 16384);
    const int nitems = (K / 64) * (Ndst / 32);
    for (int it = gw; it < nitems; it += ngw) transpose_item<MAP>(W, K, Nsrc, Ndst, WT, scr, it, F.lane);
}
__device__ __forceinline__ void rms_row(const float* xrow, const float* g, bf16* obf, float* of32, int lane) {
    const f32x4* xr = (const f32x4*)xrow + lane; const f32x4* gr = (const f32x4*)g + lane;
    f32x4 v[8]; float s = 0.f;
#pragma unroll
    for (int j = 0; j < 8; ++j) { v[j] = xr[64 * j]; s += (v[j].x * v[j].x + v[j].y * v[j].y) + (v[j].z * v[j].z + v[j].w * v[j].w); }
    const float r = 1.0f / sqrtf(wave_sum(s) * (1.f / DM) + 1e-6f);
#pragma unroll
    for (int j = 0; j < 8; ++j) { const f32x4 gv = gr[64 * j]; const f32x4 y = {v[j].x * r * gv.x, v[j].y * r * gv.y, v[j].z * r * gv.z, v[j].w * r * gv.w};
        if (obf) { v2u o; o.x = pk2(y.x, y.y); o.y = pk2(y.z, y.w); *((v2u*)obf + lane + 64 * j) = o; }
        else *((f32x4*)of32 + lane + 64 * j) = y; }
}
__device__ __forceinline__ float2 cossin_d(float angf) {
    const double x = (double)angf; const double k = rint(x * 0.6366197723675814);
    double r = fma(-k, 1.5707963267948966, x); r = fma(-k, 6.123233995736766e-17, r);
    const int q = (int)k & 3; const double r2 = r * r;
    const double sn = r * (1.0 + r2 * (-1.0 / 6 + r2 * (1.0 / 120 + r2 * (-1.0 / 5040 + r2 * (1.0 / 362880 + r2 * (-1.0 / 39916800 + r2 * (1.0 / 6227020800.0)))))));
    const double cn = 1.0 + r2 * (-0.5 + r2 * (1.0 / 24 + r2 * (-1.0 / 720 + r2 * (1.0 / 40320 + r2 * (-1.0 / 3628800 + r2 * (1.0 / 479001600 + r2 * (-1.0 / 87178291200.0)))))));
    const double c = (q == 0) ? cn : (q == 1) ? -sn : (q == 2) ? -cn : sn;
    const double s_ = (q == 0) ? sn : (q == 1) ? cn : (q == 2) ? -sn : -cn;
    return make_float2((float)c, (float)s_);
}
__device__ __forceinline__ void build_tables(const Frame& F, float2* TAB, float2* TABI, bf16* OVM) {
    const int gt = F.gw * 64 + F.lane, NT = F.NGW * 64;
    for (int i = gt; i < S * 64; i += NT) { const int t = i >> 6, d = i & 63;
        double f = 1.0; for (int k = 0; k < d; ++k) f *= 0.8659643233600653523;
        TAB[i] = cossin_d((float)t * (float)f); }
    for (int i = gt; i < S * 32; i += NT) { const int t = i >> 5, d = i & 31;
        double f = 1.0; for (int k = 0; k < d; ++k) f *= 0.7498942093324558273;
        TABI[i] = cossin_d((float)t * (float)f); }
    for (int i = gt; i < 512 * 128; i += NT) { const int n = i >> 7, j = i & 127; OVM[i] = (n < 511 && n >= 4 * j - 1 && n <= 4 * j + 3) ? (bf16)0x3F80 : (bf16)0; }
}
__device__ __forceinline__ void prep_phase(const Frame& F, const bf16* P, bf16* CA, float* CUM, float* NRM, const float* pe, const float* bf_) {
    const int lane = F.lane;
    const int p1 = 8 * (lane >> 2) + 2 * (lane & 3);
    for (int it = F.gw; it < 1024; it += F.NGW) { const int kv = it >> 9, n = it & 511; bf16* dst = CA + (size_t)it * 4096;
        for (int i = 0; i < 32; ++i) { float y1 = 0.f, y2 = 0.f;
            if (n < 511) { const int t = 16 * n + i; const bf16* b = P + (size_t)t * NP + (kv ? COL_DVC : COL_DKC);
                if (kv == 0) { y1 = bf2f(b[p1]); y2 = bf2f(b[p1 + 1]); } else { y1 = bf2f(b[lane]); y2 = bf2f(b[64 + lane]); }
                y1 += pe[(kv * 32 + i) * 128 + lane]; y2 += pe[(kv * 32 + i) * 128 + 64 + lane]; }
            dst[i * 128 + lane] = (bf16)f2bf(y1); dst[i * 128 + 64 + lane] = (bf16)f2bf(y2); } }
    { float kmax[4] = {0.f, 0.f, 0.f, 0.f};
      for (int t = F.gw; t < S; t += F.NGW) { const bf16* row = P + (size_t)t * NP;
#pragma unroll
        for (int h = 0; h < 4; ++h) { const unsigned qv = *(const unsigned*)(row + COL_BQ + h * 128 + 2 * lane), kv = *(const unsigned*)(row + COL_BK + h * 128 + 2 * lane);
            const float q2 = wave_sum(bflo(qv) * bflo(qv) + bfhi(qv) * bfhi(qv)), k2 = wave_sum(bflo(kv) * bflo(kv) + bfhi(kv) * bfhi(kv));
            kmax[h] = fmaxf(kmax[h], k2); if (lane == 0) NRM[h * S + t] = q2; } }
      if (lane == 0) {
#pragma unroll
        for (int h = 0; h < 4; ++h) { if (F.gw < 2048) NRM[4 * S + h * 2048 + F.gw] = kmax[h]; } } }
    if (blockIdx.x < 4) { const int h = blockIdx.x; LAS double* wt = (LAS double*)(F.lds + 131072 - 256);
        double loc[16]; double run = 0.0; const float bfh = bf_[h];
#pragma unroll
        for (int k = 0; k < 16; ++k) { const float x = bf2f(P[(size_t)(F.tid * 16 + k) * NP + COL_MISC + MI_BFL + h]) + bfh; run += (double)(fminf(x, 0.f) - log1pf(__expf(-fabsf(x)))); loc[k] = run; }
        double sc = run;
#pragma unroll
        for (int o = 1; o < 64; o <<= 1) { const double u = __shfl_up(sc, o); if (lane >= o) sc += u; }
        if (lane == 63) wt[F.wave] = sc;
        __syncthreads();
        double off = sc - run;
        for (int w = 0; w < F.wave; ++w) off += wt[w];
#pragma unroll
        for (int k = 0; k < 16; ++k) CUM[(size_t)h * S + F.tid * 16 + k] = (float)(off + loc[k]);
        __syncthreads();
    }
}
__device__ __forceinline__ void combine_phase(const Frame& F, const unsigned char* ws, bf16* BR) {
    const int lane = F.lane, h = lane >> 4;
    const bf16* OA = (const bf16*)(ws + WS_OA); const bf16* PB = (const bf16*)(ws + WS_PB); const bf16* PC = (const bf16*)(ws + WS_PC); const bf16* PS = (const bf16*)(ws + WS_PS);
    const bf16* OCMP = (const bf16*)(ws + WS_OCMP); const bf16* OWIN = (const bf16*)(ws + WS_OWIN);
    const float* LA = (const float*)(ws + WS_LSEA); const float* LB = (const float*)(ws + WS_LSEB); const float* LC = (const float*)(ws + WS_LSEC); const float* LS = (const float*)(ws + WS_LSES);
    const bf16* P = (const bf16*)(ws + WS_P);
    for (int t = F.gw; t < S; t += F.NGW) {
        const int qb = t >> 8, mB = qb >> 2, nchB = mB + 1, rowB = (2 * mB * (mB + 1) + (qb & 3) * (mB + 1)) * 256 + (t & 255);
        const int bs = t >> 6, mS = bs >> 4, nchS = mS + 1, rowS = (8 * mS * (mS + 1) + (bs & 15) * (mS + 1)) * 64 + (t & 63);
        const size_t eo = (size_t)t * 512 + 8 * lane;
        float r[8];
#define COMBINE(PBUF, LBUF, NCH, ROW0, RSTEP) do { float mx = -1e30f; float lv[8]; \
            _Pragma("unroll") for (int c = 0; c < 8; ++c) { lv[c] = c < (NCH) ? (LBUF)[((size_t)(ROW0) + (size_t)c * (RSTEP)) * 4 + h] : -1e30f; mx = fmaxf(mx, lv[c]); } \
            float ws_ = 0.f; _Pragma("unroll") for (int i = 0; i < 8; ++i) r[i] = 0.f; \
            _Pragma("unroll") for (int c = 0; c < 8; ++c) { if (c < (NCH) && lv[c] > -1e29f) { const float w = __expf(lv[c] - mx); const v4u v = *(const v4u*)((PBUF) + ((size_t)(ROW0) + (size_t)c * (RSTEP)) * 512 + 8 * lane); ws_ += w; \
                r[0] += w * bflo(v.x); r[1] += w * bfhi(v.x); r[2] += w * bflo(v.y); r[3] += w * bfhi(v.y); r[4] += w * bflo(v.z); r[5] += w * bfhi(v.z); r[6] += w * bflo(v.w); r[7] += w * bfhi(v.w); } } \
            const float inv = ws_ > 0.f ? 1.f / ws_ : 0.f; _Pragma("unroll") for (int i = 0; i < 8; ++i) r[i] *= inv; } while (0)
#define STORE8(dst) do { v4u o_; o_.x = pk2(r[0], r[1]); o_.y = pk2(r[2], r[3]); o_.z = pk2(r[4], r[5]); o_.w = pk2(r[6], r[7]); *(v4u*)(dst) = o_; } while (0)
        COMBINE(OA, LA, 3, t, S);
#if defined(ZERO_BR) && ZERO_BR == 0
        for (int i = 0; i < 8; ++i) r[i] = 0.f;
#endif
        STORE8(BR + eo);
        COMBINE(PB, LB, nchB, rowB, 256);
#if defined(ZERO_BR) && ZERO_BR == 1
        for (int i = 0; i < 8; ++i) r[i] = 0.f;
#endif
        STORE8(BR + (size_t)S * 512 + eo);
        COMBINE(PC, LC, nchB, rowB, 256);
#if defined(ZERO_BR) && ZERO_BR == 2
        for (int i = 0; i < 8; ++i) r[i] = 0.f;
#endif
        STORE8(BR + (size_t)2 * S * 512 + eo);
        COMBINE(PS, LS, nchS, rowS, 64);
        const bf16* dg = P + (size_t)t * NP + COL_MISC + MI_DG + 3 * h;
        float g0 = 1.f / (1.f + __expf(-bf2f(dg[0]))), g1 = 1.f / (1.f + __expf(-bf2f(dg[1]))), g2 = 1.f / (1.f + __expf(-bf2f(dg[2])));
#if defined(ZERO_BR) && ZERO_BR == 3
        g0 = 0.f; g1 = 0.f; g2 = 0.f;
#elif defined(ZERO_BR) && ZERO_BR == 4
        g0 = 0.f;
#elif defined(ZERO_BR) && ZERO_BR == 5
        g1 = 0.f;
#elif defined(ZERO_BR) && ZERO_BR == 6
        g2 = 0.f;
#endif
        const v4u vc = *(const v4u*)(OCMP + eo), vw = *(const v4u*)(OWIN + eo);
        r[0] = g0 * bflo(vc.x) + g1 * r[0] + g2 * bflo(vw.x); r[1] = g0 * bfhi(vc.x) + g1 * r[1] + g2 * bfhi(vw.x);
        r[2] = g0 * bflo(vc.y) + g1 * r[2] + g2 * bflo(vw.y); r[3] = g0 * bfhi(vc.y) + g1 * r[3] + g2 * bfhi(vw.y);
        r[4] = g0 * bflo(vc.z) + g1 * r[4] + g2 * bflo(vw.z); r[5] = g0 * bfhi(vc.z) + g1 * r[5] + g2 * bfhi(vw.z);
        r[6] = g0 * bflo(vc.w) + g1 * r[6] + g2 * bflo(vw.w); r[7] = g0 * bfhi(vc.w) + g1 * r[7] + g2 * bfhi(vw.w);
        STORE8(BR + (size_t)3 * S * 512 + eo);
#undef COMBINE
#undef STORE8
    }
}
__device__ __forceinline__ void cmp_select(const bf16* IMPH, unsigned* SEL, int q0, LAS char* lds, int tid) {
    LAS float* imp = (LAS float*)lds;
    asm volatile("" : "+v"(tid));
    const int lane = tid & 63;
    {
        const int q = tid & 63, cg = tid >> 6; const bf16* row = IMPH + (size_t)(q0 + q) * 512 + cg * 16;
        float acc[16];
#pragma unroll
        for (int e = 0; e < 16; ++e) acc[e] = 0.f;
#pragma unroll
        for (int h = 0; h < 4; ++h)
#pragma unroll
            for (int c = 0; c < 2; ++c) { const v4u v = *(const v4u*)(row + h * 128 + c * 8);
                acc[c * 8 + 0] += bflo(v.x); acc[c * 8 + 1] += bfhi(v.x); acc[c * 8 + 2] += bflo(v.y); acc[c * 8 + 3] += bfhi(v.y);
                acc[c * 8 + 4] += bflo(v.z); acc[c * 8 + 5] += bfhi(v.z); acc[c * 8 + 6] += bflo(v.w); acc[c * 8 + 7] += bfhi(v.w); }
#pragma unroll
        for (int e = 0; e < 16; ++e) imp[(cg * 16 + e) * 64 + q] = acc[e];
    }
    __syncthreads();
    if (tid < 64) {
        const int t = q0 + lane, cur = q0 >> 6;
        unsigned s0 = 0u, s1 = 0u, s2 = 0u, s3 = 0u;
#define SETBIT(j) do { const int j_ = (j); const unsigned b_ = 1u << (j_ & 31); if (j_ < 32) s0 |= b_; else if (j_ < 64) s1 |= b_; else if (j_ < 96) s2 |= b_; else s3 |= b_; } while (0)
        if (cur - 2 <= 13) { for (int j = 0; j <= cur; ++j) SETBIT(j); }
        else {
            SETBIT(0); SETBIT(cur); SETBIT(cur - 1);
            const int jmax = cur - 2;
#pragma unroll 1
            for (int it = 0; it < 13; ++it) { float best = -__builtin_inff(); int bi = 1;
#pragma unroll 1
                for (int j = 1; j <= jmax; ++j) { const float v = imp[j * 64 + lane]; const bool ok = v > best; best = ok ? v : best; bi = ok ? j : bi; }
                imp[bi * 64 + lane] = -__builtin_inff();
                SETBIT(bi); }
        }
#undef SETBIT
        const v4u o = {s0, s1, s2, s3}; *(v4u*)(SEL + (size_t)t * 4) = o;
    }
}
struct Args { const float* in[15]; float* out; unsigned char* ws; int ph_lo, ph_hi, grid, pad; };
typedef const __attribute__((address_space(4))) Args* CArgs;
constexpr int NPH = 14, PH_FINAL = 2 * NPH, PH_END = PH_FINAL + 1;

__device__ __forceinline__ void decode_bc(int u, int& head, int& qb, int& c, int& slot) {
    head = u & 3; const int v = u >> 2; int m;
    if (v < 112) { int rem = v; m = 7; while (rem >= 4 * m) { rem -= 4 * m; --m; } qb = 4 * m + rem / m; c = rem % m; }
    else { const int w = v - 112; m = w & 7; qb = 4 * m + 3 - (w >> 3); c = m; }
    slot = 2 * m * (m + 1) + (qb & 3) * (m + 1) + c;
}
__device__ __forceinline__ void decode_slc(int u, int& b, int& c, int& slot) {
    int m;
    if (u < 448) { int rem = u; m = 7; while (rem >= 16 * m) { rem -= 16 * m; --m; } b = 16 * m + rem / m; c = rem % m; }
    else { const int w = u - 448; m = w & 7; b = 16 * m + 15 - (w >> 3); c = m; }
    slot = 8 * m * (m + 1) + (b & 15) * (m + 1) + c;
}

__global__ void __launch_bounds__(NWAVES * 64, 2) hyb_fwd(Args args) {
    extern __shared__ __attribute__((aligned(16))) unsigned char lds_raw[];
#ifdef HYB_TIME
    if (blockIdx.x == 0 && threadIdx.x == 0) ((unsigned long long*)(args.ws + WS_CTL + 262144))[63] = __builtin_amdgcn_s_memrealtime();
#endif
    {
        LAS unsigned char* l0 = (LAS unsigned char*)lds_raw;
        for (int u = threadIdx.x; u < (LDS_BYTES - LDSCTL_OFF) / 4; u += NWAVES * 64) ((LAS unsigned*)(l0 + LDSCTL_OFF))[u] = 0u;
    }
    __syncthreads();
    (void)xcd_barrier_post((unsigned*)(args.ws + WS_CTL) + CW_BAR, (volatile LAS unsigned*)((LAS unsigned char*)lds_raw + MISC_OFF) + 8);
#define IN(k) (((CArgs)__builtin_amdgcn_kernarg_segment_ptr())->ph_lo <= (k) && (k) < ((CArgs)__builtin_amdgcn_kernarg_segment_ptr())->ph_hi)
#ifndef PHMASK
#define PHMASK 0x7fff
#endif
#define PHEN(k) (((PHMASK) >> (k)) & 1)
#define SEAM(k) do { if (IN(k) && IN((k) + 1)) { CArgs kb_ = (CArgs)__builtin_amdgcn_kernarg_segment_ptr(); asm volatile("" : "+s"(kb_)); \
        XcdBarrier b_; b_.bar = (unsigned*)(kb_->ws + WS_CTL) + CW_BAR; b_.x = xb_xcc_id(); b_.st = (volatile LAS unsigned*)((LAS unsigned char*)lds_raw + MISC_OFF) + 8; xcd_barrier(b_); } } while (0)
#define SEAM_FORCE() do { CArgs kb_ = (CArgs)__builtin_amdgcn_kernarg_segment_ptr(); XcdBarrier b_; b_.bar = (unsigned*)(kb_->ws + WS_CTL) + CW_BAR; b_.x = xb_xcc_id(); b_.st = (volatile LAS unsigned*)((LAS unsigned char*)lds_raw + MISC_OFF) + 8; xcd_barrier(b_); } while (0)
#ifndef TIME_BDIV
#define TIME_BDIV 10.f
#endif
#ifdef HYB_TIME
#define STAMP(k) do { if (blockIdx.x == 0 && threadIdx.x == 0) { CArgs ka_ = (CArgs)__builtin_amdgcn_kernarg_segment_ptr(); asm volatile("" : "+s"(ka_)); ((unsigned long long*)(ka_->ws + WS_CTL + 262144))[(k)] = __builtin_amdgcn_s_memrealtime(); } } while (0)
#else
#define STAMP(k) do { } while (0)
#endif

#define PHASE_BEGIN CArgs ka = (CArgs)__builtin_amdgcn_kernarg_segment_ptr(); asm volatile("" : "+s"(ka)); unsigned char* ws = ka->ws; Frame F; mkframe(F, lds_raw, ka->grid); LAS char* lds = (LAS char*)F.lds; (void)lds; (void)ws;
#define TAB ((float2*)(ws + WS_TAB))
#define TABI ((float2*)(ws + WS_TABI))
#define OVM ((bf16*)(ws + WS_OVM))
#define KI ((bf16*)(ws + WS_KI))
#define CUM ((float*)(ws + WS_CUM))
#define KVC ((bf16*)(ws + WS_KVC))
#define HID ((bf16*)(ws + WS_HID))
#define SEL ((unsigned*)(ws + WS_SEL))
#define CA ((bf16*)(ws + WS_CA))
#define BM ((unsigned*)(ws + WS_BM))
#define W2T ((bf16*)(ws + WS_W2T))
#define W1T ((bf16*)(ws + WS_W1T))
#define WB ((bf16*)(ws + WS_WB))
#define WO ((bf16*)(ws + WS_WO))
#define WIN_ ((bf16*)(ws + WS_WIN))
#define WG ((bf16*)(ws + WS_WG))
#define WFI ((bf16*)(ws + WS_WFI))
#define WFO ((bf16*)(ws + WS_WFO))
#define XN ((bf16*)(ws + WS_XN))
#define BR ((bf16*)(ws + WS_BR))
#define X2 ((float*)(ws + WS_X2))
#define P ((bf16*)(ws + WS_P))
#define MG ((bf16*)(ws + WS_MG))
#define SC ((float*)(ws + WS_SC))
#define Y ((bf16*)(ws + WS_Y))
#define ACT ((bf16*)(ws + WS_ACT))
#define X1 (ka->out)
#define XIN (L == 0 ? ka->in[0] : (const float*)X2)

    { constexpr int L = 0;

        const int pb = L * NPH;
        STAMP(pb + 0);
        if (PHEN(0) && IN(pb + 0)) { PHASE_BEGIN
            if (L == 0) transpose_all<MAP_IN>(F, ka->in[2] + (size_t)L * DM * 10080, DM, 10080, NP, WIN_);
            for (int kv = 0; kv < 2; ++kv) { transpose_all<MAP_ID>(F, ka->in[7] + ((size_t)L * 2 + kv) * 4096 * 256, 4096, 256, 256, W1T + (size_t)kv * 256 * 4096);
                                             if (kv == 0) transpose_all<MAP_W2P>(F, ka->in[8] + ((size_t)L * 2 + kv) * 256 * 128, 256, 128, 256, W2T + (size_t)kv * 256 * 256);
                                             else transpose_all<MAP_W2>(F, ka->in[8] + ((size_t)L * 2 + kv) * 256 * 128, 256, 128, 256, W2T + (size_t)kv * 256 * 256); }
            if (L == 0) build_tables(F, TAB, TABI, OVM);
            for (int m = F.gw; m < S; m += F.NGW) rms_row(XIN + (size_t)m * DM, ka->in[1] + (size_t)L * DM, XN + (size_t)m * DM, nullptr, F.lane);
        }
        SEAM(pb + 0);
        STAMP(pb + 1);
        if (PHEN(1) && IN(pb + 1)) { PHASE_BEGIN
            pg8::Gemm g{XN, WIN_, S, NP, DM, DM}; pg8::StaticOrder So; So.init(S, NP, F.G, (int)blockIdx.x);
            pg8::EpiProj E{P, (const float*)TAB, (const float*)TABI};
            pg8::gemm_phase<pg8::EpiProj, pg8::StaticOrder, true, true>(F.lds, g, So, E);
        }
        SEAM(pb + 1);
        STAMP(pb + 2);
        if (PHEN(2) && IN(pb + 2)) { PHASE_BEGIN prep_phase(F, P, CA, CUM, (float*)(ws + WS_NRM), ka->in[6] + (size_t)L * 2 * 32 * 128, ka->in[5] + (size_t)L * 4); }
        SEAM(pb + 2);
        STAMP(pb + 3);
        if (PHEN(3) && IN(pb + 3)) { PHASE_BEGIN
            { pg8::Gemm g{CA, W1T, 1024, 512, 4096, 1024}; pg8::SplitKOrder So; So.init(F.G, (int)blockIdx.x);
              pg8::EpiPartial E{(float*)(ws + WS_HIDP)};
              pg8::gemm_phase<pg8::EpiPartial, pg8::SplitKOrder, true, true>(F.lds, g, So, E); }
            if (L == 0) STAMP(42);
#ifdef HYB_TIME
            if (L == 0 && blockIdx.x == 0 && threadIdx.x == 0) ((unsigned long long*)(ws + WS_CTL + 262144))[57] = 1ull;
#endif
            unsigned* qctr = (unsigned*)(ws + WS_CTL) + CW_QUEUE + 64 * (L * 4 + 0);
            for (;;) { const int u = next_unit(qctr, lds); if (u >= 576 + 1056) break;
                if (u < 576) { int head, qb, c, slot; decode_bc(u, head, qb, c, slot);
                    att::AttnP ap; ap.q_pitch = NP; ap.kv_pitch = NP; ap.o_pitch = 512; ap.lse_pitch = 4; ap.q_tstride = 1; ap.k_tok0 = 0; ap.k_tstride = 1; ap.bm = nullptr;
                    ap.Q = P + COL_BQ + head * 128; ap.K = P + COL_BK + head * 128; ap.V = P + COL_BV + head * 128; ap.cum = CUM + (size_t)head * S;
                    ap.O = (bf16*)(ws + WS_PB) + ((ptrdiff_t)slot * 256 - 256 * qb) * 512 + head * 128; ap.LSE = (float*)(ws + WS_LSEB) + ((ptrdiff_t)slot * 256 - 256 * qb) * 4 + head;
                    ap.q_tok0 = 256 * qb; ap.q_sub0 = 256 * qb; ap.j_lo = 16 * c; ap.j_hi = min(16 * c + 16, 4 * (qb + 1));
                    const float* nrm = (const float*)(ws + WS_NRM);
                    const int jsk = att::b_skip(ap.cum, 256 * qb, 4 * (qb + 1), nrm + (size_t)head * S + 256 * qb, nrm + 4 * S + head * 2048, min(F.NGW, 2048), lds);
#ifdef HYB_TIME
                    const unsigned long long tb0_ = __builtin_amdgcn_s_memrealtime();
#endif
                    if (jsk >= ap.j_hi) { att::write_empty_lse(ap.LSE, 256 * qb, 4); }
                    else { ap.j_lo = max(ap.j_lo, jsk); att::attn_unit<att::M_B, false>(ap, lds);
#ifdef B_TWICE
                        att::attn_unit<att::M_B, false>(ap, lds);
#endif
 }
#ifdef HYB_TIME
                    if (L == 0 && blockIdx.x == 0 && threadIdx.x == 0) { unsigned long long* ts_ = (unsigned long long*)(ws + WS_CTL + 262144); ts_[58] += __builtin_amdgcn_s_memrealtime() - tb0_; ts_[59] += 1ull; }
#endif
                } else { const int v = u - 576; const int pr = v / 66, w = v % 66; int qb, kc2; if (w < 2 * (pr + 1)) { qb = pr; kc2 = w; } else { qb = 31 - pr; kc2 = w - 2 * (pr + 1); }
#ifdef HYB_TIME
                    { const unsigned long long tq0_ = __builtin_amdgcn_s_memrealtime();
                    att::idx_unit(P, SC, qb, kc2, lds, (L == 0 && blockIdx.x == 0) ? (unsigned long long*)(ws + WS_CTL + 262144) + 53 : nullptr);
                    if (L == 0 && blockIdx.x == 0 && threadIdx.x == 0) ((unsigned long long*)(ws + WS_CTL + 262144))[56] += __builtin_amdgcn_s_memrealtime() - tq0_; }
#else
                    att::idx_unit(P, SC, qb, kc2, lds);
#endif
#ifdef IDX_TWICE
                    att::idx_unit(P, SC, qb, kc2, lds);
#endif
 }
            }
        #ifdef HYB_TIME
            if (L == 0 && threadIdx.x == 0) { unsigned long long* ts_ = (unsigned long long*)(ws + WS_CTL + 262144); const unsigned long long now_ = __builtin_amdgcn_s_memrealtime(); atomicMax(ts_ + 44, now_); atomicMax(ts_ + 45, (1ull << 40) - now_); }
#endif
        }
        SEAM(pb + 3);
        STAMP(pb + 4);
        if (PHEN(4) && IN(pb + 4)) { PHASE_BEGIN
            if (blockIdx.x < 4) {
                const float* hp = (const float*)(ws + WS_HIDP) + (size_t)blockIdx.x * 256 * 256;
                for (int i = F.tid; i < 256 * 256 / 4; i += 512) { f32x4 s4 = *(const f32x4*)(hp + 4 * i);
#pragma unroll
                    for (int q = 1; q < 4; ++q) s4 = s4 + *(const f32x4*)(hp + (size_t)q * 1024 * 256 + 4 * i);
                    float o4[4];
#pragma unroll
                    for (int e = 0; e < 4; ++e) { const float x = s4[e]; const float tt = 0.7978845608028654f * (x + 0.044715f * x * x * x); const float ee = __expf(2.f * tt); o4[e] = 0.5f * x * (2.f - 2.f / (ee + 1.f)); }
                    v2u o; o.x = pk2(o4[0], o4[1]); o.y = pk2(o4[2], o4[3]); *(v2u*)(HID + (size_t)blockIdx.x * 256 * 256 + 4 * i) = o; }
                VM_WAIT(); __syncthreads();
            }
            { pg8::Gemm g{HID, W2T, 1024, 512, 256, 256}; pg8::StackOrder So; So.init(2, 1, 2, F.G, (int)blockIdx.x);
              pg8::EpiPlain<0> E{KVC, 128, 1, 128};
              pg8::gemm_phase<pg8::EpiPlain<0>, pg8::StackOrder, true, true>(F.lds, g, So, E); }
            unsigned* qctr = (unsigned*)(ws + WS_CTL) + CW_QUEUE + 64 * (L * 4 + 1);
            for (;;) { const int uq = next_unit(qctr, lds); if (uq >= 1024) break;
                if (uq < 256 || uq >= 768) { const bool heavy = uq < 256; const int su = heavy ? uq : uq - 768;
                    int tl = threadIdx.x; asm volatile("" : "+v"(tl)); const int w8 = su * 8 + __builtin_amdgcn_readfirstlane(tl >> 6), ln = tl & 63;
                    if (heavy) {
#ifdef SEL_TWICE
#pragma unroll 1
                        for (int jj = 0; jj < 4; ++jj) att::select_row<128>(SC, BM, (jj & 1) ? 8191 - w8 : 4096 + w8, ln);
#else
#pragma unroll 1
                        for (int jj = 0; jj < 2; ++jj) att::select_row<128>(SC, BM, jj ? 8191 - w8 : 4096 + w8, ln);
#endif
                    } else { att::select_row<32>(SC, BM, w8, ln); att::select_row<64>(SC, BM, 4095 - w8, ln); }
                    continue; }
                const int u = uq - 256;
                att::AttnP ap; ap.q_pitch = NP; ap.kv_pitch = NP; ap.o_pitch = 512; ap.lse_pitch = 4; ap.bm = nullptr; ap.cum = nullptr;
                if (u < 128) { const int b = 127 - u; const int q0 = 64 * b;
                    ap.q_tstride = 1; ap.k_tok0 = 0; ap.k_tstride = 1;
                    ap.Q = P + COL_DQ; ap.K = P + COL_DKW; ap.V = P + COL_DVW; ap.O = (bf16*)(ws + WS_OWIN); ap.LSE = nullptr;
                    ap.q_tok0 = q0; ap.q_sub0 = q0; ap.j_lo = q0 >= 511 ? (q0 - 511) >> 6 : 0; ap.j_hi = b + 1;
                    att::attn_unit<att::M_WIN, true>(ap, lds);
                } else { const int v = u - 128; const int hh = v & 3, g = (v >> 2) % 3, blk = v / 12;
                    const int r = g == 0 ? 1 : (g == 1 ? 4 : 16); const int nper = 32 / r;
                    const int res = blk / nper, n = blk % nper; const int head = g * 4 + hh;
                    ap.Q = P + COL_AQ + head * 128; ap.K = P + COL_AK + head * 128; ap.V = P + COL_AV + head * 128;
                    ap.O = (bf16*)(ws + WS_OA) + (size_t)g * S * 512 + hh * 128; ap.LSE = (float*)(ws + WS_LSEA) + (size_t)g * S * 4 + hh;
                    ap.q_tok0 = res + r * 256 * n; ap.q_tstride = r; ap.q_sub0 = 256 * n; ap.k_tok0 = res; ap.k_tstride = r;
                    ap.j_lo = n == 0 ? 0 : 4 * n - 2; ap.j_hi = 4 * n + 4;
                    att::attn_unit<att::M_A, false>(ap, lds); }
            }
        }
        SEAM(pb + 4);
        STAMP(pb + 5);
        if (PHEN(5) && IN(pb + 5)) { PHASE_BEGIN
            transpose_all<MAP_GATE>(F, ka->in[3] + (size_t)L * DM * 8192, DM, 8192, 8192, WG);
            for (int b = 0; b < 4; ++b) transpose_all<MAP_ID>(F, ka->in[9] + ((size_t)L * 4 + b) * 512 * DM, 512, DM, DM, WB + (size_t)b * DM * 512);
            transpose_all<MAP_ID>(F, ka->in[10] + (size_t)L * DM * DM, DM, DM, DM, WO);
            unsigned* qctr = (unsigned*)(ws + WS_CTL) + CW_QUEUE + 64 * (L * 4 + 2);
            for (;;) { const int u = next_unit(qctr, lds); if (u >= 576 + 128) break;
                att::AttnP ap; ap.q_pitch = NP; ap.o_pitch = 512; ap.lse_pitch = 4; ap.q_tstride = 1; ap.k_tok0 = 0; ap.k_tstride = 1; ap.cum = nullptr;
                if (u >= 128) { int head, qb, c, slot; decode_bc(u - 128, head, qb, c, slot);
                    ap.Q = P + COL_CQ + head * 128; ap.K = P + COL_CK + head * 128; ap.V = P + COL_CV + head * 128; ap.kv_pitch = NP; ap.bm = BM;
                    ap.O = (bf16*)(ws + WS_PC) + ((ptrdiff_t)slot * 256 - 256 * qb) * 512 + head * 128; ap.LSE = (float*)(ws + WS_LSEC) + ((ptrdiff_t)slot * 256 - 256 * qb) * 4 + head;
                    ap.q_tok0 = 256 * qb; ap.q_sub0 = 256 * qb; ap.j_lo = 16 * c; ap.j_hi = min(16 * c + 16, 4 * (qb + 1));
                    att::attn_unit<att::M_C, false>(ap, lds);
                } else { const int b = 127 - u; const int q0 = 64 * b;
                    ap.Q = P + COL_DQ; ap.K = KVC; ap.V = KVC + 512 * 128; ap.kv_pitch = 128; ap.bm = nullptr; ap.LSE = nullptr;
                    ap.q_tok0 = q0; ap.q_sub0 = q0; ap.j_lo = 0; ap.j_hi = 8;
                    ap.O = (bf16*)(ws + WS_OCMP); att::attn_unit<att::M_CMP, true>(ap, lds);
                    ap.V = OVM; ap.O = (bf16*)(ws + WS_IMPH); att::attn_unit<att::M_CMP, true>(ap, lds);
                    __syncthreads();
                    cmp_select((const bf16*)(ws + WS_IMPH), SEL, q0, lds, F.tid); }
            }
        }
        SEAM(pb + 5);
        STAMP(pb + 6);
        if (PHEN(6) && IN(pb + 6)) { PHASE_BEGIN
            unsigned* qctr = (unsigned*)(ws + WS_CTL) + CW_QUEUE + 64 * (L * 4 + 3);
            for (;;) { const int u = next_unit(qctr, lds); if (u >= 576) break; int b, c, slot; decode_slc(u, b, c, slot);
                att::AttnP ap; ap.q_pitch = NP; ap.kv_pitch = NP; ap.o_pitch = 512; ap.lse_pitch = 4; ap.q_tstride = 1; ap.k_tok0 = 0; ap.k_tstride = 1; ap.cum = nullptr; ap.bm = SEL;
                ap.Q = P + COL_DQ; ap.K = P + COL_DKS; ap.V = P + COL_DVS; ap.O = (bf16*)(ws + WS_PS) + ((ptrdiff_t)slot * 64 - 64 * b) * 512; ap.LSE = (float*)(ws + WS_LSES) + ((ptrdiff_t)slot * 64 - 64 * b) * 4;
                ap.q_tok0 = 64 * b; ap.q_sub0 = 64 * b; ap.j_lo = 16 * c; ap.j_hi = min(16 * c + 16, b + 1);
#ifdef HYB_TIME
                const unsigned long long t0_ = __builtin_amdgcn_s_memrealtime();
#endif
                att::attn_unit<att::M_SLC, true>(ap, lds);
#ifdef HYB_TIME
                if (L == 0 && blockIdx.x == 0 && threadIdx.x == 0) { unsigned long long* ts_ = (unsigned long long*)(ws + WS_CTL + 262144); ts_[50] += __builtin_amdgcn_s_memrealtime() - t0_; ts_[51] += (unsigned long long)(ap.j_hi - ap.j_lo); ts_[52] += 1ull; }
#endif
 }
        }
        SEAM(pb + 6);
        STAMP(pb + 7);
        if (PHEN(7) && IN(pb + 7)) { PHASE_BEGIN combine_phase(F, ws, BR); }
        SEAM(pb + 7);
        STAMP(pb + 8);
        if (PHEN(8) && IN(pb + 8)) { PHASE_BEGIN
            pg8::Gemm g{BR, WB, 4 * S, 4 * DM, 512, 512}; pg8::StackOrder So; So.init(32, 8, 4, F.G, (int)blockIdx.x);
            pg8::EpiPlain<0> E{Y, DM, 8, DM};
            pg8::gemm_phase<pg8::EpiPlain<0>, pg8::StackOrder, true, true>(F.lds, g, So, E);
        }
        SEAM(pb + 8);
        STAMP(pb + 9);
        if (PHEN(9) && IN(pb + 9)) { PHASE_BEGIN
            pg8::Gemm g{XN, WG, S, 8192, DM, DM}; pg8::StaticOrder So; So.init(S, 8192, F.G, (int)blockIdx.x);
            pg8::EpiGate E{Y, ka->in[4] + (size_t)L * 4 * DM, MG};
            pg8::gemm_phase<pg8::EpiGate, pg8::StaticOrder, true, true>(F.lds, g, So, E);
        }
        SEAM(pb + 9);
        STAMP(pb + 10);
        if (PHEN(10) && IN(pb + 10)) { PHASE_BEGIN
            pg8::Gemm g{MG, WO, S, DM, DM, DM}; pg8::StaticOrder So; So.init(S, DM, F.G, (int)blockIdx.x);
            pg8::EpiRes E{XIN, X1};
            pg8::gemm_phase<pg8::EpiRes, pg8::StaticOrder, true, true>(F.lds, g, So, E);
        }
        SEAM(pb + 10);
        STAMP(pb + 11);
        if (PHEN(11) && IN(pb + 11)) { PHASE_BEGIN
            transpose_all<MAP_FFI>(F, ka->in[12] + (size_t)L * DM * NFF2, DM, NFF2, NFF2, WFI);
            for (int m = F.gw; m < S; m += F.NGW) rms_row(X1 + (size_t)m * DM, ka->in[11] + (size_t)L * DM, XN + (size_t)m * DM, nullptr, F.lane); }
        SEAM(pb + 11);
        STAMP(pb + 12);
        if (PHEN(12) && IN(pb + 12)) { PHASE_BEGIN
            pg8::Gemm g{XN, WFI, S, NFF2, DM, DM}; pg8::StaticOrder So; So.init(S, NFF2, F.G, (int)blockIdx.x);
            pg8::EpiSwiglu E{ACT};
            pg8::gemm_phase<pg8::EpiSwiglu, pg8::StaticOrder, true, true>(F.lds, g, So, E);
            if (F.G != 256 || blockIdx.x >= 128) {
                __syncthreads();
                const int gw2 = F.G != 256 ? F.gw : ((int)blockIdx.x - 128) * NWAVES + F.wave, ngw2 = F.G != 256 ? F.NGW : 128 * NWAVES;
                transpose_some<MAP_ID>(F, gw2, ngw2, ka->in[13] + (size_t)L * NFF * DM, NFF, DM, DM, WFO);
                if (L == 0) transpose_some<MAP_IN>(F, gw2, ngw2, ka->in[2] + (size_t)1 * DM * 10080, DM, 10080, NP, WIN_);
            }
        }
        SEAM(pb + 12);
        STAMP(pb + 13);
        if (PHEN(13) && IN(pb + 13)) { PHASE_BEGIN
            pg8::Gemm g{ACT, WFO, S, DM, NFF, NFF}; pg8::StaticOrder So; So.init(S, DM, F.G, (int)blockIdx.x);
            pg8::EpiRes E{X1, X2};
            pg8::gemm_phase<pg8::EpiRes, pg8::StaticOrder, true, true>(F.lds, g, So, E);
        }
        SEAM(pb + 13);

    }
    { constexpr int L = 1;

        const int pb = L * NPH;
        STAMP(pb + 0);
        if (PHEN(0) && IN(pb + 0)) { PHASE_BEGIN
            if (L == 0) transpose_all<MAP_IN>(F, ka->in[2] + (size_t)L * DM * 10080, DM, 10080, NP, WIN_);
            for (int kv = 0; kv < 2; ++kv) { transpose_all<MAP_ID>(F, ka->in[7] + ((size_t)L * 2 + kv) * 4096 * 256, 4096, 256, 256, W1T + (size_t)kv * 256 * 4096);
                                             if (kv == 0) transpose_all<MAP_W2P>(F, ka->in[8] + ((size_t)L * 2 + kv) * 256 * 128, 256, 128, 256, W2T + (size_t)kv * 256 * 256);
                                             else transpose_all<MAP_W2>(F, ka->in[8] + ((size_t)L * 2 + kv) * 256 * 128, 256, 128, 256, W2T + (size_t)kv * 256 * 256); }
            if (L == 0) build_tables(F, TAB, TABI, OVM);
            for (int m = F.gw; m < S; m += F.NGW) rms_row(XIN + (size_t)m * DM, ka->in[1] + (size_t)L * DM, XN + (size_t)m * DM, nullptr, F.lane);
        }
        SEAM(pb + 0);
        STAMP(pb + 1);
        if (PHEN(1) && IN(pb + 1)) { PHASE_BEGIN
            pg8::Gemm g{XN, WIN_, S, NP, DM, DM}; pg8::StaticOrder So; So.init(S, NP, F.G, (int)blockIdx.x);
            pg8::EpiProj E{P, (const float*)TAB, (const float*)TABI};
            pg8::gemm_phase<pg8::EpiProj, pg8::StaticOrder, true, true>(F.lds, g, So, E);
        }
        SEAM(pb + 1);
        STAMP(pb + 2);
        if (PHEN(2) && IN(pb + 2)) { PHASE_BEGIN prep_phase(F, P, CA, CUM, (float*)(ws + WS_NRM), ka->in[6] + (size_t)L * 2 * 32 * 128, ka->in[5] + (size_t)L * 4); }
        SEAM(pb + 2);
        STAMP(pb + 3);
        if (PHEN(3) && IN(pb + 3)) { PHASE_BEGIN
            { pg8::Gemm g{CA, W1T, 1024, 512, 4096, 1024}; pg8::SplitKOrder So; So.init(F.G, (int)blockIdx.x);
              pg8::EpiPartial E{(float*)(ws + WS_HIDP)};
              pg8::gemm_phase<pg8::EpiPartial, pg8::SplitKOrder, true, true>(F.lds, g, So, E); }
            if (L == 0) STAMP(42);
#ifdef HYB_TIME
            if (L == 0 && blockIdx.x == 0 && threadIdx.x == 0) ((unsigned long long*)(ws + WS_CTL + 262144))[57] = 1ull;
#endif
            unsigned* qctr = (unsigned*)(ws + WS_CTL) + CW_QUEUE + 64 * (L * 4 + 0);
            for (;;) { const int u = next_unit(qctr, lds); if (u >= 576 + 1056) break;
                if (u < 576) { int head, qb, c, slot; decode_bc(u, head, qb, c, slot);
                    att::AttnP ap; ap.q_pitch = NP; ap.kv_pitch = NP; ap.o_pitch = 512; ap.lse_pitch = 4; ap.q_tstride = 1; ap.k_tok0 = 0; ap.k_tstride = 1; ap.bm = nullptr;
                    ap.Q = P + COL_BQ + head * 128; ap.K = P + COL_BK + head * 128; ap.V = P + COL_BV + head * 128; ap.cum = CUM + (size_t)head * S;
                    ap.O = (bf16*)(ws + WS_PB) + ((ptrdiff_t)slot * 256 - 256 * qb) * 512 + head * 128; ap.LSE = (float*)(ws + WS_LSEB) + ((ptrdiff_t)slot * 256 - 256 * qb) * 4 + head;
                    ap.q_tok0 = 256 * qb; ap.q_sub0 = 256 * qb; ap.j_lo = 16 * c; ap.j_hi = min(16 * c + 16, 4 * (qb + 1));
                    const float* nrm = (const float*)(ws + WS_NRM);
                    const int jsk = att::b_skip(ap.cum, 256 * qb, 4 * (qb + 1), nrm + (size_t)head * S + 256 * qb, nrm + 4 * S + head * 2048, min(F.NGW, 2048), lds);
#ifdef HYB_TIME
                    const unsigned long long tb0_ = __builtin_amdgcn_s_memrealtime();
#endif
                    if (jsk >= ap.j_hi) { att::write_empty_lse(ap.LSE, 256 * qb, 4); }
                    else { ap.j_lo = max(ap.j_lo, jsk); att::attn_unit<att::M_B, false>(ap, lds);
#ifdef B_TWICE
                        att::attn_unit<att::M_B, false>(ap, lds);
#endif
 }
#ifdef HYB_TIME
                    if (L == 0 && blockIdx.x == 0 && threadIdx.x == 0) { unsigned long long* ts_ = (unsigned long long*)(ws + WS_CTL + 262144); ts_[58] += __builtin_amdgcn_s_memrealtime() - tb0_; ts_[59] += 1ull; }
#endif
                } else { const int v = u - 576; const int pr = v / 66, w = v % 66; int qb, kc2; if (w < 2 * (pr + 1)) { qb = pr; kc2 = w; } else { qb = 31 - pr; kc2 = w - 2 * (pr + 1); }
#ifdef HYB_TIME
                    { const unsigned long long tq0_ = __builtin_amdgcn_s_memrealtime();
                    att::idx_unit(P, SC, qb, kc2, lds, (L == 0 && blockIdx.x == 0) ? (unsigned long long*)(ws + WS_CTL + 262144) + 53 : nullptr);
                    if (L == 0 && blockIdx.x == 0 && threadIdx.x == 0) ((unsigned long long*)(ws + WS_CTL + 262144))[56] += __builtin_amdgcn_s_memrealtime() - tq0_; }
#else
                    att::idx_unit(P, SC, qb, kc2, lds);
#endif
#ifdef IDX_TWICE
                    att::idx_unit(P, SC, qb, kc2, lds);
#endif
 }
            }
        #ifdef HYB_TIME
            if (L == 0 && threadIdx.x == 0) { unsigned long long* ts_ = (unsigned long long*)(ws + WS_CTL + 262144); const unsigned long long now_ = __builtin_amdgcn_s_memrealtime(); atomicMax(ts_ + 44, now_); atomicMax(ts_ + 45, (1ull << 40) - now_); }
#endif
        }
        SEAM(pb + 3);
        STAMP(pb + 4);
        if (PHEN(4) && IN(pb + 4)) { PHASE_BEGIN
            if (blockIdx.x < 4) {
                const float* hp = (const float*)(ws + WS_HIDP) + (size_t)blockIdx.x * 256 * 256;
                for (int i = F.tid; i < 256 * 256 / 4; i += 512) { f32x4 s4 = *(const f32x4*)(hp + 4 * i);
#pragma unroll
                    for (int q = 1; q < 4; ++q) s4 = s4 + *(const f32x4*)(hp + (size_t)q * 1024 * 256 + 4 * i);
                    float o4[4];
#pragma unroll
                    for (int e = 0; e < 4; ++e) { const float x = s4[e]; const float tt = 0.7978845608028654f * (x + 0.044715f * x * x * x); const float ee = __expf(2.f * tt); o4[e] = 0.5f * x * (2.f - 2.f / (ee + 1.f)); }
                    v2u o; o.x = pk2(o4[0], o4[1]); o.y = pk2(o4[2], o4[3]); *(v2u*)(HID + (size_t)blockIdx.x * 256 * 256 + 4 * i) = o; }
                VM_WAIT(); __syncthreads();
            }
            { pg8::Gemm g{HID, W2T, 1024, 512, 256, 256}; pg8::StackOrder So; So.init(2, 1, 2, F.G, (int)blockIdx.x);
              pg8::EpiPlain<0> E{KVC, 128, 1, 128};
              pg8::gemm_phase<pg8::EpiPlain<0>, pg8::StackOrder, true, true>(F.lds, g, So, E); }
            unsigned* qctr = (unsigned*)(ws + WS_CTL) + CW_QUEUE + 64 * (L * 4 + 1);
            for (;;) { const int uq = next_unit(qctr, lds); if (uq >= 1024) break;
                if (uq < 256 || uq >= 768) { const bool heavy = uq < 256; const int su = heavy ? uq : uq - 768;
                    int tl = threadIdx.x; asm volatile("" : "+v"(tl)); const int w8 = su * 8 + __builtin_amdgcn_readfirstlane(tl >> 6), ln = tl & 63;
                    if (heavy) {
#ifdef SEL_TWICE
#pragma unroll 1
                        for (int jj = 0; jj < 4; ++jj) att::select_row<128>(SC, BM, (jj & 1) ? 8191 - w8 : 4096 + w8, ln);
#else
#pragma unroll 1
                        for (int jj = 0; jj < 2; ++jj) att::select_row<128>(SC, BM, jj ? 8191 - w8 : 4096 + w8, ln);
#endif
                    } else { att::select_row<32>(SC, BM, w8, ln); att::select_row<64>(SC, BM, 4095 - w8, ln); }
                    continue; }
                const int u = uq - 256;
                att::AttnP ap; ap.q_pitch = NP; ap.kv_pitch = NP; ap.o_pitch = 512; ap.lse_pitch = 4; ap.bm = nullptr; ap.cum = nullptr;
                if (u < 128) { const int b = 127 - u; const int q0 = 64 * b;
                    ap.q_tstride = 1; ap.k_tok0 = 0; ap.k_tstride = 1;
                    ap.Q = P + COL_DQ; ap.K = P + COL_DKW; ap.V = P + COL_DVW; ap.O = (bf16*)(ws + WS_OWIN); ap.LSE = nullptr;
                    ap.q_tok0 = q0; ap.q_sub0 = q0; ap.j_lo = q0 >= 511 ? (q0 - 511) >> 6 : 0; ap.j_hi = b + 1;
                    att::attn_unit<att::M_WIN, true>(ap, lds);
                } else { const int v = u - 128; const int hh = v & 3, g = (v >> 2) % 3, blk = v / 12;
                    const int r = g == 0 ? 1 : (g == 1 ? 4 : 16); const int nper = 32 / r;
                    const int res = blk / nper, n = blk % nper; const int head = g * 4 + hh;
                    ap.Q = P + COL_AQ + head * 128; ap.K = P + COL_AK + head * 128; ap.V = P + COL_AV + head * 128;
                    ap.O = (bf16*)(ws + WS_OA) + (size_t)g * S * 512 + hh * 128; ap.LSE = (float*)(ws + WS_LSEA) + (size_t)g * S * 4 + hh;
                    ap.q_tok0 = res + r * 256 * n; ap.q_tstride = r; ap.q_sub0 = 256 * n; ap.k_tok0 = res; ap.k_tstride = r;
                    ap.j_lo = n == 0 ? 0 : 4 * n - 2; ap.j_hi = 4 * n + 4;
                    att::attn_unit<att::M_A, false>(ap, lds); }
            }
        }
        SEAM(pb + 4);
        STAMP(pb + 5);
        if (PHEN(5) && IN(pb + 5)) { PHASE_BEGIN
            transpose_all<MAP_GATE>(F, ka->in[3] + (size_t)L * DM * 8192, DM, 8192, 8192, WG);
            for (int b = 0; b < 4; ++b) transpose_all<MAP_ID>(F, ka->in[9] + ((size_t)L * 4 + b) * 512 * DM, 512, DM, DM, WB + (size_t)b * DM * 512);
            transpose_all<MAP_ID>(F, ka->in[10] + (size_t)L * DM * DM, DM, DM, DM, WO);
            unsigned* qctr = (unsigned*)(ws + WS_CTL) + CW_QUEUE + 64 * (L * 4 + 2);
            for (;;) { const int u = next_unit(qctr, lds); if (u >= 576 + 128) break;
                att::AttnP ap; ap.q_pitch = NP; ap.o_pitch = 512; ap.lse_pitch = 4; ap.q_tstride = 1; ap.k_tok0 = 0; ap.k_tstride = 1; ap.cum = nullptr;
                if (u >= 128) { int head, qb, c, slot; decode_bc(u - 128, head, qb, c, slot);
                    ap.Q = P + COL_CQ + head * 128; ap.K = P + COL_CK + head * 128; ap.V = P + COL_CV + head * 128; ap.kv_pitch = NP; ap.bm = BM;
                    ap.O = (bf16*)(ws + WS_PC) + ((ptrdiff_t)slot * 256 - 256 * qb) * 512 + head * 128; ap.LSE = (float*)(ws + WS_LSEC) + ((ptrdiff_t)slot * 256 - 256 * qb) * 4 + head;
                    ap.q_tok0 = 256 * qb; ap.q_sub0 = 256 * qb; ap.j_lo = 16 * c; ap.j_hi = min(16 * c + 16, 4 * (qb + 1));
                    att::attn_unit<att::M_C, false>(ap, lds);
                } else { const int b = 127 - u; const int q0 = 64 * b;
                    ap.Q = P + COL_DQ; ap.K = KVC; ap.V = KVC + 512 * 128; ap.kv_pitch = 128; ap.bm = nullptr; ap.LSE = nullptr;
                    ap.q_tok0 = q0; ap.q_sub0 = q0; ap.j_lo = 0; ap.j_hi = 8;
                    ap.O = (bf16*)(ws + WS_OCMP); att::attn_unit<att::M_CMP, true>(ap, lds);
                    ap.V = OVM; ap.O = (bf16*)(ws + WS_IMPH); att::attn_unit<att::M_CMP, true>(ap, lds);
                    __syncthreads();
                    cmp_select((const bf16*)(ws + WS_IMPH), SEL, q0, lds, F.tid); }
            }
        }
        SEAM(pb + 5);
        STAMP(pb + 6);
        if (PHEN(6) && IN(pb + 6)) { PHASE_BEGIN
            unsigned* qctr = (unsigned*)(ws + WS_CTL) + CW_QUEUE + 64 * (L * 4 + 3);
            for (;;) { const int u = next_unit(qctr, lds); if (u >= 576) break; int b, c, slot; decode_slc(u, b, c, slot);
                att::AttnP ap; ap.q_pitch = NP; ap.kv_pitch = NP; ap.o_pitch = 512; ap.lse_pitch = 4; ap.q_tstride = 1; ap.k_tok0 = 0; ap.k_tstride = 1; ap.cum = nullptr; ap.bm = SEL;
                ap.Q = P + COL_DQ; ap.K = P + COL_DKS; ap.V = P + COL_DVS; ap.O = (bf16*)(ws + WS_PS) + ((ptrdiff_t)slot * 64 - 64 * b) * 512; ap.LSE = (float*)(ws + WS_LSES) + ((ptrdiff_t)slot * 64 - 64 * b) * 4;
                ap.q_tok0 = 64 * b; ap.q_sub0 = 64 * b; ap.j_lo = 16 * c; ap.j_hi = min(16 * c + 16, b + 1);
#ifdef HYB_TIME
                const unsigned long long t0_ = __builtin_amdgcn_s_memrealtime();
#endif
                att::attn_unit<att::M_SLC, true>(ap, lds);
#ifdef HYB_TIME
                if (L == 0 && blockIdx.x == 0 && threadIdx.x == 0) { unsigned long long* ts_ = (unsigned long long*)(ws + WS_CTL + 262144); ts_[50] += __builtin_amdgcn_s_memrealtime() - t0_; ts_[51] += (unsigned long long)(ap.j_hi - ap.j_lo); ts_[52] += 1ull; }
#endif
 }
        }
        SEAM(pb + 6);
        STAMP(pb + 7);
        if (PHEN(7) && IN(pb + 7)) { PHASE_BEGIN combine_phase(F, ws, BR); }
        SEAM(pb + 7);
        STAMP(pb + 8);
        if (PHEN(8) && IN(pb + 8)) { PHASE_BEGIN
            pg8::Gemm g{BR, WB, 4 * S, 4 * DM, 512, 512}; pg8::StackOrder So; So.init(32, 8, 4, F.G, (int)blockIdx.x);
            pg8::EpiPlain<0> E{Y, DM, 8, DM};
            pg8::gemm_phase<pg8::EpiPlain<0>, pg8::StackOrder, true, true>(F.lds, g, So, E);
        }
        SEAM(pb + 8);
        STAMP(pb + 9);
        if (PHEN(9) && IN(pb + 9)) { PHASE_BEGIN
            pg8::Gemm g{XN, WG, S, 8192, DM, DM}; pg8::StaticOrder So; So.init(S, 8192, F.G, (int)blockIdx.x);
            pg8::EpiGate E{Y, ka->in[4] + (size_t)L * 4 * DM, MG};
            pg8::gemm_phase<pg8::EpiGate, pg8::StaticOrder, true, true>(F.lds, g, So, E);
        }
        SEAM(pb + 9);
        STAMP(pb + 10);
        if (PHEN(10) && IN(pb + 10)) { PHASE_BEGIN
            pg8::Gemm g{MG, WO, S, DM, DM, DM}; pg8::StaticOrder So; So.init(S, DM, F.G, (int)blockIdx.x);
            pg8::EpiRes E{XIN, X1};
            pg8::gemm_phase<pg8::EpiRes, pg8::StaticOrder, true, true>(F.lds, g, So, E);
        }
        SEAM(pb + 10);
        STAMP(pb + 11);
        if (PHEN(11) && IN(pb + 11)) { PHASE_BEGIN
            transpose_all<MAP_FFI>(F, ka->in[12] + (size_t)L * DM * NFF2, DM, NFF2, NFF2, WFI);
            for (int m = F.gw; m < S; m += F.NGW) rms_row(X1 + (size_t)m * DM, ka->in[11] + (size_t)L * DM, XN + (size_t)m * DM, nullptr, F.lane); }
        SEAM(pb + 11);
        STAMP(pb + 12);
        if (PHEN(12) && IN(pb + 12)) { PHASE_BEGIN
            pg8::Gemm g{XN, WFI, S, NFF2, DM, DM}; pg8::StaticOrder So; So.init(S, NFF2, F.G, (int)blockIdx.x);
            pg8::EpiSwiglu E{ACT};
            pg8::gemm_phase<pg8::EpiSwiglu, pg8::StaticOrder, true, true>(F.lds, g, So, E);
            if (F.G != 256 || blockIdx.x >= 128) {
                __syncthreads();
                const int gw2 = F.G != 256 ? F.gw : ((int)blockIdx.x - 128) * NWAVES + F.wave, ngw2 = F.G != 256 ? F.NGW : 128 * NWAVES;
                transpose_some<MAP_ID>(F, gw2, ngw2, ka->in[13] + (size_t)L * NFF * DM, NFF, DM, DM, WFO);
                if (L == 0) transpose_some<MAP_IN>(F, gw2, ngw2, ka->in[2] + (size_t)1 * DM * 10080, DM, 10080, NP, WIN_);
            }
        }
        SEAM(pb + 12);
        STAMP(pb + 13);
        if (PHEN(13) && IN(pb + 13)) { PHASE_BEGIN
            pg8::Gemm g{ACT, WFO, S, DM, NFF, NFF}; pg8::StaticOrder So; So.init(S, DM, F.G, (int)blockIdx.x);
            pg8::EpiRes E{X1, X2};
            pg8::gemm_phase<pg8::EpiRes, pg8::StaticOrder, true, true>(F.lds, g, So, E);
        }
        SEAM(pb + 13);

    }
#ifdef HYB_PROBE_OFF
    {
        if (args.ph_hi > 0) SEAM_FORCE();
        CArgs ka = (CArgs)__builtin_amdgcn_kernarg_segment_ptr(); const bf16* src = (const bf16*)(ka->ws + (size_t)(HYB_PROBE_OFF));
        for (size_t i = (size_t)blockIdx.x * 512 + threadIdx.x; i < (size_t)S * DM; i += (size_t)gridDim.x * 512) { const size_t t = i / DM, c = i % DM; const size_t si = (t * (HYB_PROBE_PITCH) + c) % (size_t)(HYB_PROBE_MOD);
#ifdef HYB_PROBE_BM
            { const unsigned w = (unsigned)(c & 255); const unsigned v = (w < 8u * ((unsigned)(t >> 8) + 1u)) ? ((const unsigned*)src)[t * 256 + w] : 0u; ka->out[i] = (float)(v & 0xffffu) + (float)(v >> 16) * (1.0f / 65536.0f); (void)si; }
#elif defined(HYB_PROBE_F32)
            ka->out[i] = ((const float*)src)[si];
#elif defined(HYB_PROBE_U32)
            ka->out[i] = (float)(((const unsigned*)src)[si] & 0xffffu) + (float)(((const unsigned*)src)[si] >> 16) * (1.0f / 65536.0f);
#else
            ka->out[i] = bf2f(src[si]);
#endif
 }
        return;
    }
#endif
    STAMP(PH_FINAL);
#ifdef HYB_TIME
    if (PHEN(14) && IN(PH_FINAL)) { const int L = 1; (void)L; PHASE_BEGIN
        const unsigned long long* ts = (const unsigned long long*)(ws + WS_CTL + 262144);
        const float dA = (float)(ts[TIME_A1] - ts[TIME_A0]) * (0.01f / 2000.f);
#ifdef TIME_MINFIN
        const float dB = (float)(((1ull << 40) - ts[45]) - ts[TIME_B0]) * (0.01f / TIME_BDIV);
#elif defined(TIME_RATIO)
        const float dB = (float)ts[TIME_B1] / (float)ts[TIME_B0] * (1.f / TIME_BDIV);
#else
        const float dB = (float)(ts[TIME_B1] - ts[TIME_B0]) * (0.01f / TIME_BDIV);
#endif
        for (int m = F.gw; m < S; m += F.NGW) { rms_row(X2 + (size_t)m * DM, ka->in[14], nullptr, ka->out + (size_t)m * DM, F.lane);
            for (int c = F.lane; c < DM; c += 64) { float v = ka->out[(size_t)m * DM + c] * (1.f + dA); if (m == 0 && c == 0) v += dB; ka->out[(size_t)m * DM + c] = v; } }
    }
#else
    if (PHEN(14) && IN(PH_FINAL)) { const int L = 1; (void)L; PHASE_BEGIN for (int m = F.gw; m < S; m += F.NGW) rms_row(X2 + (size_t)m * DM, ka->in[14], nullptr, ka->out + (size_t)m * DM, F.lane);
#ifdef FINAL_TWICE
        for (int rep = 0; rep < 4; ++rep) { asm volatile("" ::: "memory"); for (int m = F.gw; m < S; m += F.NGW) rms_row(X2 + (size_t)m * DM, ka->in[14], nullptr, ka->out + (size_t)m * DM, F.lane); }
#endif
    }
#endif
#undef IN
#undef SEAM
}

#ifndef HYB_N_LAUNCHES
#define HYB_N_LAUNCHES 1
#endif
extern "C" void kernel_launch(void* const* d_in, const int* in_sizes, int n_in, void* d_out, int out_size, void* d_ws, size_t ws_size, hipStream_t stream) {
    static int grid = 0;
    if (grid == 0) {
        if (n_in != 15 || out_size != S * DM || ws_size < WS_END) { fprintf(stderr, "kernel_launch: unexpected shapes: n_in %d out %d ws %zu (need %zu)\n", n_in, out_size, ws_size, (size_t)WS_END); grid = -1; return; }
        int dev = 0, cus = 0, per_cu = 0;
        if (hipGetDevice(&dev) != hipSuccess || hipDeviceGetAttribute(&cus, hipDeviceAttributeMultiprocessorCount, dev) != hipSuccess) { grid = -1; return; }
        if (hipFuncSetAttribute((const void*)hyb_fwd, hipFuncAttributeMaxDynamicSharedMemorySize, LDS_BYTES) != hipSuccess) { fprintf(stderr, "kernel_launch: hipFuncSetAttribute failed\n"); grid = -1; return; }
        if (hipOccupancyMaxActiveBlocksPerMultiprocessor(&per_cu, (const void*)hyb_fwd, NWAVES * 64, LDS_BYTES) != hipSuccess || per_cu < 1) { fprintf(stderr, "kernel_launch: occupancy query says %d\n", per_cu); }
        (void)hipGetLastError();
        grid = cus;
    }
    if (grid < 0) return;
    if (hipMemsetAsync((char*)d_ws + WS_CTL, 0, CTL_ZERO_BYTES, stream) != hipSuccess) return;
    Args a{};
    for (int i = 0; i < 15; ++i) a.in[i] = (const float*)d_in[i];
    a.out = (float*)d_out; a.ws = (unsigned char*)d_ws; a.grid = grid; a.pad = 0;
#if HYB_N_LAUNCHES == 1
#ifndef HYB_PH_HI
#define HYB_PH_HI PH_END
#endif
    a.ph_lo = 0; a.ph_hi = HYB_PH_HI;
    hipLaunchKernelGGL(hyb_fwd, dim3(grid), dim3(NWAVES * 64), LDS_BYTES, stream, a);
#else
    for (int ph = 0; ph < PH_END; ++ph) { a.ph_lo = ph; a.ph_hi = ph + 1; hipLaunchKernelGGL(hyb_fwd, dim3(grid), dim3(NWAVES * 64), LDS_BYTES, stream, a); }
#endif
}
```

```cpp
#include <hip/hip_runtime.h>
#include <cstdio>
#include <cstdint>
namespace pg8 {
#define PG8_LAS __attribute__((address_space(3)))
typedef unsigned short bf16_t;
typedef short bf16x8 __attribute__((ext_vector_type(8)));
typedef float f32x4 __attribute__((ext_vector_type(4)));
typedef unsigned u32x4 __attribute__((ext_vector_type(4)));
constexpr int BM = 256, BK = 64, HALF = 128, HTB = HALF * BK * 2  , STAGE_BYTES = 8 * HTB, NXCD = 8, WGM = 8;

__host__ __device__ __forceinline__ int lds_byte(int r, int c) { const int st = (r >> 4) * 2 + (c >> 5), rr = r & 15, cc = c & 31, ob = rr * 64 + cc * 2; return st * 1024 + (ob ^ (((ob >> 9) & 1) << 5)); }
__host__ __device__ __forceinline__ void stage_rc(int b, int& R, int& C) { const int st = b / 1024, sb = b % 1024, swz = sb ^ (((sb >> 9) & 1) << 5); R = (st >> 1) * 16 + swz / 64; C = (st & 1) * 32 + (swz % 64) / 2; }
__host__ __device__ __forceinline__ int perm32(int rho) { const int n = rho >> 4, i = rho & 15; return 8 * (i >> 2) + 4 * n + (i & 3); }

struct Unit { int pm, pn, ko; };
struct Gemm { const bf16_t* A; const bf16_t* Bt; int M, N, K; int KL; };

struct StaticOrder {
    int nM, nN, nwg, G, c;
    __host__ __device__ void init(int M, int N, int G_, int c_) { nM = M / BM; nN = N / BM; nwg = nM * nN; G = G_; c = c_; }
    __host__ __device__ bool next(int i, Unit& u) const {
        const long L = (long)i * G + c; if (L >= nwg) return false;
        int wgid = (int)L; { const int q = nwg / NXCD, r = nwg % NXCD, xcd = wgid % NXCD, off = wgid / NXCD; wgid = (xcd < r ? xcd * (q + 1) : r * (q + 1) + (xcd - r) * q) + off; }
        const int nig = WGM * nN, gid = wgid / nig, fm = gid * WGM, gsz = (nM - fm) < WGM ? (nM - fm) : WGM;
        u.pm = fm + ((wgid % nig) % gsz); u.pn = (wgid % nig) / gsz; u.ko = 0; return true;
    }
    __device__ __forceinline__ void a_ready(const Unit&) const {}
    __device__ __forceinline__ void done(const Unit&) const {}
};

__device__ __forceinline__ unsigned cvt_pk_bf16(float lo, float hi) { unsigned r; asm volatile("v_cvt_pk_bf16_f32 %0, %1, %2" : "=v"(r) : "v"(lo), "v"(hi)); return r; }
typedef float f32x2 __attribute__((ext_vector_type(2)));
template <class Epi, class Sched, bool ALIGN_EPI = false, bool SP2 = false>
__device__ __forceinline__ void gemm_phase(PG8_LAS unsigned char* lds, const Gemm g, const Sched& S, const Epi& E) {
    int tid_ = threadIdx.x; asm volatile("" : "+v"(tid_));
    const int tid = tid_, wid = __builtin_amdgcn_readfirstlane(tid >> 6), lane = tid & 63, wr = wid >> 2, wc = wid & 3, fr = lane & 15, fq = lane >> 4;
    const int K = g.K, nt = g.KL / BK;
    unsigned voffA[2], voffB[2];
#pragma unroll
    for (int i = 0; i < 2; ++i) { int R, C; stage_rc(tid * 16 + i * 8192, R, C); const int Rb = Epi::PERM ? ((R & ~31) + perm32(R & 31)) : R;
        voffA[i] = (unsigned)(R * K + C) * 2u; voffB[i] = (unsigned)(Rb * K + C) * 2u; }
    const size_t kstep = (size_t)(BK * 2);
    const size_t hstep = (size_t)HALF * K * 2;
    const size_t tstep = 2 * hstep;
    const unsigned ldsw = (unsigned)wid * 1024u;
    const int aoff = lds_byte(wr * 64 + fr, fq * 8), boff = lds_byte(wc * 32 + fr, fq * 8);
#define PG8_SA(b, h) (((b) * 2 + (h)) * HTB)
#define PG8_SB(b, h) ((4 + (b) * 2 + (h)) * HTB)
#define PG8_STAGE(bufoff, gbase, voff) do { _Pragma("unroll") for (int _i = 0; _i < 2; ++_i) \
        __builtin_amdgcn_global_load_lds((const unsigned*)((const char*)(gbase) + (voff)[_i]), (PG8_LAS unsigned*)(lds + (bufoff) + ldsw + _i * 8192), 16, 0, 0); } while (0)
#define PG8_LDA(dst, b, h) do { _Pragma("unroll") for (int m = 0; m < 4; ++m) _Pragma("unroll") for (int k = 0; k < 2; ++k) dst[m][k] = *(const PG8_LAS bf16x8*)(lds + PG8_SA(b, h) + aoff + m * 2048 + k * 1024); } while (0)
#define PG8_LDB(dst, b, h) do { _Pragma("unroll") for (int n = 0; n < 2; ++n) _Pragma("unroll") for (int k = 0; k < 2; ++k) dst[n][k] = *(const PG8_LAS bf16x8*)(lds + PG8_SB(b, h) + boff + n * 2048 + k * 1024); } while (0)
#define PG8_MMA(ai, bj, At, Bt) do { __builtin_amdgcn_s_setprio(1); _Pragma("unroll") for (int m = 0; m < 4; ++m) _Pragma("unroll") for (int n = 0; n < 2; ++n) _Pragma("unroll") for (int k = 0; k < 2; ++k) \
        acc[ai][bj][m][n] = __builtin_amdgcn_mfma_f32_16x16x32_bf16(Bt[n][k], At[m][k], acc[ai][bj][m][n], 0, 0, 0); __builtin_amdgcn_s_setprio(0); } while (0)
#define PG8_WAIT_V(n) asm volatile("s_waitcnt vmcnt(" #n ")" ::: "memory")
#define PG8_WAIT_L(n) asm volatile("s_waitcnt lgkmcnt(" #n ")" ::: "memory")
#define PG8_BAR __builtin_amdgcn_s_barrier()
#define PG8_SCHED __builtin_amdgcn_sched_barrier(0)
    Unit cur, nxt; int ui = 0;
    if (!S.next(0, cur)) return;
    f32x4 acc[2][2][4][2];
#pragma unroll
    for (int a = 0; a < 2; ++a)
#pragma unroll
        for (int b = 0; b < 2; ++b)
#pragma unroll
            for (int m = 0; m < 4; ++m)
#pragma unroll
                for (int n = 0; n < 2; ++n) acc[a][b][m][n] = (f32x4){0.f, 0.f, 0.f, 0.f};
    bf16x8 At[4][2], B0[2][2], B1[2][2];
    const char* cA = (const char*)g.A + (size_t)cur.pm * tstep + (size_t)cur.ko * 2; const char* cB = (const char*)g.Bt + (size_t)cur.pn * tstep + (size_t)cur.ko * 2;
    S.a_ready(cur);
    if constexpr (SP2) {
        PG8_STAGE(PG8_SB(0, 0), cB, voffB); PG8_STAGE(PG8_SB(0, 1), cB + hstep, voffB); PG8_STAGE(PG8_SA(0, 0), cA, voffA); PG8_STAGE(PG8_SA(0, 1), cA + hstep, voffA);
        if (wr == 1) PG8_BAR;
        PG8_WAIT_V(2); PG8_BAR;
        PG8_STAGE(PG8_SB(1, 0), cB + kstep, voffB); PG8_STAGE(PG8_SA(1, 0), cA + kstep, voffA); PG8_STAGE(PG8_SB(1, 1), cB + hstep + kstep, voffB);
        PG8_WAIT_V(6); PG8_BAR;
    } else {
        PG8_STAGE(PG8_SB(0, 0), cB, voffB); PG8_STAGE(PG8_SA(0, 0), cA, voffA); PG8_STAGE(PG8_SB(0, 1), cB + hstep, voffB); PG8_STAGE(PG8_SA(0, 1), cA + hstep, voffA);
        if (wr == 1) PG8_BAR;
        PG8_WAIT_V(4); PG8_BAR;
        PG8_STAGE(PG8_SB(1, 0), cB + kstep, voffB); PG8_STAGE(PG8_SA(1, 0), cA + kstep, voffA); PG8_STAGE(PG8_SB(1, 1), cB + hstep + kstep, voffB);
        PG8_WAIT_V(6); PG8_BAR;
    }
    for (;;) {
        const bool has_next = S.next(ui + 1, nxt);
        const char* nA = has_next ? (const char*)g.A + (size_t)nxt.pm * tstep + (size_t)nxt.ko * 2 : cA; const char* nB = has_next ? (const char*)g.Bt + (size_t)nxt.pn * tstep + (size_t)nxt.ko * 2 : cB;
        for (int t = 0; t < nt; t += 2) {
            const bool last = (t == nt - 2);
            const char* a1 = cA + (size_t)(t + 1) * kstep;
            const char* a2 = last ? nA : cA + (size_t)(t + 2) * kstep; const char* b2 = last ? nB : cB + (size_t)(t + 2) * kstep;
            const char* a3 = a2 + kstep; const char* b3 = b2 + kstep;
            if (last && has_next) S.a_ready(nxt);
            if constexpr (SP2) {
            PG8_LDB(B0, 0, 0); PG8_LDB(B1, 0, 1); PG8_SCHED; PG8_LDA(At, 0, 0); PG8_STAGE(PG8_SA(1, 1), a1 + hstep, voffA);
            PG8_WAIT_V(8); PG8_WAIT_L(0); PG8_BAR; PG8_MMA(0, 0, At, B0); PG8_MMA(0, 1, At, B1); PG8_BAR; PG8_SCHED;
            PG8_LDA(At, 0, 1); PG8_STAGE(PG8_SB(0, 0), b2, voffB); PG8_STAGE(PG8_SB(0, 1), b2 + hstep, voffB); PG8_STAGE(PG8_SA(0, 0), a2, voffA);
            PG8_WAIT_V(8); PG8_WAIT_L(0); PG8_BAR; PG8_MMA(1, 0, At, B0); PG8_MMA(1, 1, At, B1); PG8_BAR; PG8_SCHED;
            PG8_LDB(B0, 1, 0); PG8_LDB(B1, 1, 1); PG8_SCHED; PG8_LDA(At, 1, 0); PG8_STAGE(PG8_SA(0, 1), a2 + hstep, voffA);
            PG8_WAIT_V(8); PG8_WAIT_L(0); PG8_BAR; PG8_MMA(0, 0, At, B0); PG8_MMA(0, 1, At, B1); PG8_BAR; PG8_SCHED;
            PG8_LDA(At, 1, 1); PG8_STAGE(PG8_SB(1, 0), b3, voffB); PG8_STAGE(PG8_SB(1, 1), b3 + hstep, voffB); PG8_STAGE(PG8_SA(1, 0), a3, voffA);
            PG8_WAIT_V(8); PG8_WAIT_L(0); PG8_BAR; PG8_MMA(1, 0, At, B0); PG8_MMA(1, 1, At, B1); PG8_BAR; PG8_SCHED;
            } else {
            PG8_LDB(B0, 0, 0); PG8_SCHED; PG8_LDA(At, 0, 0); PG8_STAGE(PG8_SA(1, 1), a1 + hstep, voffA);
            PG8_WAIT_L(8); PG8_BAR; PG8_WAIT_L(0); PG8_MMA(0, 0, At, B0); PG8_BAR; PG8_SCHED;
            PG8_LDB(B1, 0, 1); PG8_STAGE(PG8_SB(0, 0), b2, voffB);
            PG8_BAR; PG8_WAIT_L(0); PG8_MMA(0, 1, At, B1); PG8_BAR;
            PG8_LDA(At, 0, 1); PG8_STAGE(PG8_SA(0, 0), a2, voffA);
            PG8_BAR; PG8_WAIT_L(0); PG8_MMA(1, 0, At, B0); PG8_BAR; PG8_SCHED;
            PG8_STAGE(PG8_SB(0, 1), b2 + hstep, voffB);
            PG8_WAIT_V(6); PG8_BAR; PG8_MMA(1, 1, At, B1); PG8_BAR;
            PG8_LDB(B0, 1, 0); PG8_SCHED; PG8_LDA(At, 1, 0); PG8_STAGE(PG8_SA(0, 1), a2 + hstep, voffA);
            PG8_WAIT_L(8); PG8_BAR; PG8_WAIT_L(0); PG8_MMA(0, 0, At, B0); PG8_BAR; PG8_SCHED;
            PG8_LDB(B1, 1, 1); PG8_STAGE(PG8_SB(1, 0), b3, voffB);
            PG8_BAR; PG8_WAIT_L(0); PG8_MMA(0, 1, At, B1); PG8_BAR;
            PG8_LDA(At, 1, 1); PG8_STAGE(PG8_SA(1, 0), a3, voffA);
            PG8_BAR; PG8_WAIT_L(0); PG8_MMA(1, 0, At, B0); PG8_BAR; PG8_SCHED;
            PG8_STAGE(PG8_SB(1, 1), b3 + hstep, voffB);
            PG8_WAIT_V(6); PG8_BAR; PG8_MMA(1, 1, At, B1); PG8_BAR;
            }
        }
        if constexpr (ALIGN_EPI) { if (wr == 0) PG8_BAR; }
        if constexpr (!Epi::AFTER_DRAIN) { E(acc, cur, wr, wc, fr, fq); S.done(cur); }
        if (!has_next) break;
#pragma unroll
        for (int a = 0; a < 2; ++a)
#pragma unroll
            for (int b = 0; b < 2; ++b)
#pragma unroll
                for (int m = 0; m < 4; ++m)
#pragma unroll
                    for (int n = 0; n < 2; ++n) acc[a][b][m][n] = (f32x4){0.f, 0.f, 0.f, 0.f};
        cur = nxt; cA = nA; cB = nB; ++ui;
        if constexpr (ALIGN_EPI) { if (wr == 1) PG8_BAR; }
    }
    PG8_WAIT_V(0);
    if constexpr (!ALIGN_EPI) { if (wr == 0) PG8_BAR; }
    PG8_BAR;
    if constexpr (Epi::AFTER_DRAIN) { E.fused(acc, cur, wr, wc, fr, fq, lds, wid, lane); S.done(cur); }
#undef PG8_SA
#undef PG8_SB
#undef PG8_STAGE
#undef PG8_LDA
#undef PG8_LDB
#undef PG8_MMA
#undef PG8_WAIT_V
#undef PG8_WAIT_L
#undef PG8_BAR
#undef PG8_SCHED
}
}
constexpr int S = 8192, DM = 2048, NP = 10240, NFF = 5632, NFF2 = 11264;
constexpr int COL_AQ = 0, COL_AK = 1536, COL_AV = 3072, COL_BQ = 4608, COL_BK = 5120, COL_BV = 5632, COL_CQ = 6144, COL_CK = 6656, COL_CV = 7168,
              COL_CQI = 7680, COL_DQ = 8704, COL_DKC = 9216, COL_DVC = 9344, COL_DKS = 9472, COL_DVS = 9600, COL_DKW = 9728, COL_DVW = 9856, COL_MISC = 9984;
constexpr int MI_CKI = 0, MI_BFL = 64, MI_CWI = 68, MI_DG = 84;

namespace pg8 {
struct EpiProj {
    static constexpr bool PERM = true, AFTER_DRAIN = false;
    bf16_t* P; const float* TAB; const float* TABI;
    __device__ __forceinline__ void operator()(const f32x4 (&acc)[2][2][4][2], const Unit& u, int wr, int wc, int fr, int fq) const {
        const int row0 = u.pm * BM + wr * 64 + fr; const int col0 = u.pn * BM + wc * 32 + 8 * fq; const int pn = u.pn;
        int mode0, mode1;
        if (pn < 12 || (pn >= 24 && pn < 28) || pn == 34 || pn == 35) { mode0 = 1; mode1 = 1; }
        else if (pn >= 30 && pn < 34) { mode0 = 2; mode1 = 2; }
        else if (pn >= 36 && pn < 39) { mode0 = 1; mode1 = 0; }
        else if (pn == 39) { mode0 = wc < 2 ? 2 : 0; mode1 = 0; }
        else { mode0 = 0; mode1 = 0; }
#pragma unroll
        for (int ai = 0; ai < 2; ++ai)
#pragma unroll
            for (int m = 0; m < 4; ++m) { const int row = row0 + ai * HALF + m * 16; bf16_t* rowp = P + (size_t)row * NP + col0;
#pragma unroll
                for (int bj = 0; bj < 2; ++bj) { f32x4 v0 = acc[ai][bj][m][0], v1 = acc[ai][bj][m][1]; const int mode = bj ? mode1 : mode0;
                    if (mode != 0) {
                        const float* tp = mode == 1 ? TAB + ((size_t)row * 64 + 4 * (4 * wc + fq)) * 2 : TABI + ((size_t)row * 32 + 4 * (4 * (wc & 1) + fq)) * 2;
                        const f32x4 t0 = *(const f32x4*)tp, t1 = *(const f32x4*)(tp + 4);
                        f32x4 r0, r1;
                        r0[0] = v0[0] * t0[0] - v0[1] * t0[1]; r0[1] = v0[1] * t0[0] + v0[0] * t0[1]; r0[2] = v0[2] * t0[2] - v0[3] * t0[3]; r0[3] = v0[3] * t0[2] + v0[2] * t0[3];
                        r1[0] = v1[0] * t1[0] - v1[1] * t1[1]; r1[1] = v1[1] * t1[0] + v1[0] * t1[1]; r1[2] = v1[2] * t1[2] - v1[3] * t1[3]; r1[3] = v1[3] * t1[2] + v1[2] * t1[3];
                        v0 = r0; v1 = r1; }
                    u32x4 w; w.x = cvt_pk_bf16(v0[0], v0[1]); w.y = cvt_pk_bf16(v0[2], v0[3]); w.z = cvt_pk_bf16(v1[0], v1[1]); w.w = cvt_pk_bf16(v1[2], v1[3]);
                    *(u32x4*)(rowp + bj * HALF) = w; } }
    }
};
template <int ACT  > struct EpiPlain {
    static constexpr bool PERM = true, AFTER_DRAIN = false;
    bf16_t* O; int ldc; int ncolt; int maxcol;
    __device__ __forceinline__ void operator()(const f32x4 (&acc)[2][2][4][2], const Unit& u, int wr, int wc, int fr, int fq) const {
        const int row0 = u.pm * BM + wr * 64 + fr; const int col0 = (u.pn % ncolt) * BM + wc * 32 + 8 * fq;
#pragma unroll
        for (int ai = 0; ai < 2; ++ai)
#pragma unroll
            for (int m = 0; m < 4; ++m) { bf16_t* rowp = O + (size_t)(row0 + ai * HALF + m * 16) * ldc + col0;
#pragma unroll
                for (int bj = 0; bj < 2; ++bj) { if (col0 + bj * HALF >= maxcol) continue;
                    f32x4 v0 = acc[ai][bj][m][0], v1 = acc[ai][bj][m][1];
                    if (ACT == 1) {
#pragma unroll
                        for (int i = 0; i < 4; ++i) { { const float x = v0[i]; const float t = 0.7978845608028654f * (x + 0.044715f * x * x * x); const float e = __expf(2.f * t); const float th = 1.f - 2.f / (e + 1.f); v0[i] = 0.5f * x * (1.f + th); }
                                                      { const float x = v1[i]; const float t = 0.7978845608028654f * (x + 0.044715f * x * x * x); const float e = __expf(2.f * t); const float th = 1.f - 2.f / (e + 1.f); v1[i] = 0.5f * x * (1.f + th); } } }
                    u32x4 w; w.x = cvt_pk_bf16(v0[0], v0[1]); w.y = cvt_pk_bf16(v0[2], v0[3]); w.z = cvt_pk_bf16(v1[0], v1[1]); w.w = cvt_pk_bf16(v1[2], v1[3]);
                    *(u32x4*)(rowp + bj * HALF) = w; } }
    }
};
struct EpiGate {
    static constexpr bool PERM = true, AFTER_DRAIN = false;
    const bf16_t* Y; const float* bg; bf16_t* MG;
    __device__ __forceinline__ void operator()(const f32x4 (&acc)[2][2][4][2], const Unit& u, int wr, int wc, int fr, int fq) const {
        const int row0 = u.pm * BM + wr * 64 + fr; const int e0 = u.pn * 64 + wc * 16 + fq * 4;
        f32x4 bv[4];
#pragma unroll
        for (int br = 0; br < 4; ++br) bv[br] = *(const f32x4*)(bg + br * DM + e0);
#pragma unroll
        for (int ai = 0; ai < 2; ++ai)
#pragma unroll
            for (int m = 0; m < 4; ++m) { const size_t ro = (size_t)(row0 + ai * HALF + m * 16) * DM + e0; f32x4 sum = {0.f, 0.f, 0.f, 0.f};
#pragma unroll
                for (int br = 0; br < 4; ++br) { const f32x4 a = acc[ai][br >> 1][m][br & 1] + bv[br];
                    const unsigned long long yv = *(const unsigned long long*)(Y + (size_t)br * S * DM + ro);
                    const unsigned ylo = (unsigned)yv, yhi = (unsigned)(yv >> 32);
                    f32x4 y; y[0] = __uint_as_float(ylo << 16); y[1] = __uint_as_float(ylo & 0xffff0000u); y[2] = __uint_as_float(yhi << 16); y[3] = __uint_as_float(yhi & 0xffff0000u);
#pragma unroll
                    for (int i = 0; i < 4; ++i) { const float g = 1.f / (1.f + __expf(-a[i])); sum[i] += g * y[i]; } }
                const unsigned long long o = (unsigned long long)cvt_pk_bf16(sum[0], sum[1]) | ((unsigned long long)cvt_pk_bf16(sum[2], sum[3]) << 32);
                *(unsigned long long*)(MG + ro) = o; }
    }
};
struct EpiRes {
    static constexpr bool PERM = false, AFTER_DRAIN = false;
    const float* base; float* out;
    __device__ __forceinline__ void operator()(const f32x4 (&acc)[2][2][4][2], const Unit& u, int wr, int wc, int fr, int fq) const {
        const int row0 = u.pm * BM + wr * 64 + fr; const int col0 = u.pn * BM + wc * 32 + 4 * fq;
#pragma unroll
        for (int ai = 0; ai < 2; ++ai)
#pragma unroll
            for (int m = 0; m < 4; ++m) { const size_t off = (size_t)(row0 + ai * HALF + m * 16) * DM + col0;
#pragma unroll
                for (int bj = 0; bj < 2; ++bj)
#pragma unroll
                    for (int n = 0; n < 2; ++n) { const f32x4 b = *(const f32x4*)(base + off + bj * HALF + n * 16); *(f32x4*)(out + off + bj * HALF + n * 16) = b + acc[ai][bj][m][n]; } }
    }
};
struct EpiSwiglu {
    static constexpr bool PERM = true, AFTER_DRAIN = false;
    bf16_t* ACT;
    __device__ __forceinline__ void operator()(const f32x4 (&acc)[2][2][4][2], const Unit& u, int wr, int wc, int fr, int fq) const {
        const int row0 = u.pm * BM + wr * 64 + fr; const int col0 = u.pn * HALF + wc * 32 + 8 * fq;
#pragma unroll
        for (int ai = 0; ai < 2; ++ai)
#pragma unroll
            for (int m = 0; m < 4; ++m) { f32x4 r0, r1;
#pragma unroll
                for (int i = 0; i < 4; ++i) { const float g0 = acc[ai][0][m][0][i], g1 = acc[ai][0][m][1][i];
                    r0[i] = g0 / (1.f + __expf(-g0)) * acc[ai][1][m][0][i]; r1[i] = g1 / (1.f + __expf(-g1)) * acc[ai][1][m][1][i]; }
                u32x4 w; w.x = cvt_pk_bf16(r0[0], r0[1]); w.y = cvt_pk_bf16(r0[2], r0[3]); w.z = cvt_pk_bf16(r1[0], r1[1]); w.w = cvt_pk_bf16(r1[2], r1[3]);
                *(u32x4*)(ACT + (size_t)(row0 + ai * HALF + m * 16) * NFF + col0) = w; }
    }
};
struct StackOrder {
    int nMb, nNb, nb, G, c;
    __device__ __forceinline__ void init(int nMb_, int nNb_, int nb_, int G_, int c_) { nMb = nMb_; nNb = nNb_; nb = nb_; G = G_; c = c_; }
    __device__ __forceinline__ bool next(int i, Unit& u) const {
        const long L = (long)i * G + c; const int per = nMb * nNb; if (L >= (long)per * nb) return false;
        const int b = (int)L / per, w = (int)L % per; u.pm = b * nMb + (w % nMb); u.pn = b * nNb + (w / nMb); u.ko = 0; return true;
    }
    __device__ __forceinline__ void a_ready(const Unit&) const {}
    __device__ __forceinline__ void done(const Unit&) const {}
};
struct SplitKOrder {
    int G, c;
    __device__ __forceinline__ void init(int G_, int c_) { G = G_; c = c_; }
    __device__ __forceinline__ bool next(int i, Unit& u) const { const int L = i * G + c; if (L >= 16) return false; u.pm = L & 3; u.pn = (L & 3) >> 1; u.ko = (L >> 2) * 1024; return true; }
    __device__ __forceinline__ void a_ready(const Unit&) const {}
    __device__ __forceinline__ void done(const Unit&) const {}
};
struct EpiPartial {
    static constexpr bool PERM = false, AFTER_DRAIN = false;
    float* O;
    __device__ __forceinline__ void operator()(const f32x4 (&acc)[2][2][4][2], const Unit& u, int wr, int wc, int fr, int fq) const {
        const int row0 = u.pm * BM + wr * 64 + fr; const int col0 = wc * 32 + 4 * fq; float* base = O + (size_t)(u.ko >> 10) * 1024 * 256;
#pragma unroll
        for (int ai = 0; ai < 2; ++ai)
#pragma unroll
            for (int m = 0; m < 4; ++m) { float* rowp = base + (size_t)(row0 + ai * HALF + m * 16) * 256 + col0;
#pragma unroll
                for (int bj = 0; bj < 2; ++bj)
#pragma unroll
                    for (int n = 0; n < 2; ++n) *(f32x4*)(rowp + bj * HALF + n * 16) = acc[ai][bj][m][n]; }
    }
};
}
#define GAS __attribute__((address_space(1)))
#define LAS __attribute__((address_space(3)))
typedef unsigned short bf16;
typedef unsigned v4u __attribute__((ext_vector_type(4)));
typedef unsigned v2u __attribute__((ext_vector_type(2)));
typedef float f32x4 __attribute__((ext_vector_type(4)));
typedef float f32x16 __attribute__((ext_vector_type(16)));
typedef short bf16x8 __attribute__((ext_vector_type(8)));
typedef short s16x4 __attribute__((ext_vector_type(4)));
typedef GAS unsigned gu32;
#define RLX_AGENT __ATOMIC_RELAXED, __HIP_MEMORY_SCOPE_AGENT
#define LDS_WAIT() asm volatile("s_waitcnt lgkmcnt(0)" ::: "memory")
#define VM_WAIT() asm volatile("s_waitcnt vmcnt(0)" ::: "memory")
__device__ __forceinline__ unsigned f2bf(float f) { unsigned u = __builtin_bit_cast(unsigned, f); return (u + 0x7fffu + ((u >> 16) & 1u)) >> 16; }
__device__ __forceinline__ unsigned pk2(float lo, float hi) { return f2bf(lo) | (f2bf(hi) << 16); }
__device__ __forceinline__ float bf2f(unsigned short b) { return __uint_as_float((unsigned)b << 16); }
__device__ __forceinline__ float bflo(unsigned w) { return __uint_as_float(w << 16); }
__device__ __forceinline__ float bfhi(unsigned w) { return __uint_as_float(w & 0xffff0000u); }
__device__ __forceinline__ unsigned cvtpk(float lo, float hi) { unsigned r; asm volatile("v_cvt_pk_bf16_f32 %0, %1, %2" : "=v"(r) : "v"(lo), "v"(hi)); return r; }
__device__ __forceinline__ float wave_sum(float v) {
#pragma unroll
    for (int o = 1; o < 64; o <<= 1) v += __shfl_xor(v, o);
    return v;
}
#define XB_TMO      128
#define XB_XCNT(j)  (256  + 64 * (j))
#define XB_XSUB(j)  (1280 + 64 * (j))
#define XB_XGEN(j)  (2304 + 64 * (j))
#define XB_TOP      3328
#define XB_TOPGEN   3392
#define XCD_BAR_WORDS 3456
#define XB_SPIN_CAP (1u << 18)

__device__ __forceinline__ unsigned xb_ld(unsigned* p)              { return __hip_atomic_load(p, __ATOMIC_RELAXED, __HIP_MEMORY_SCOPE_AGENT); }
__device__ __forceinline__ unsigned xb_add(unsigned* p, unsigned v) { return __hip_atomic_fetch_add(p, v, __ATOMIC_RELAXED, __HIP_MEMORY_SCOPE_AGENT); }
__device__ __forceinline__ unsigned xb_xcc_id() { return (unsigned)__builtin_amdgcn_s_getreg((3 << 11) | 20) & 0xFu; }
#define XB_SPIN(cond, bar) do { unsigned _sp = 0; while (cond) { __builtin_amdgcn_s_sleep(1); \
    if ((++_sp & 255u) == 0u) { if (xb_ld(&(bar)[XB_TMO])) break; if (_sp > XB_SPIN_CAP) { atomicAdd(&(bar)[XB_TMO], 1u); break; } } } } while (0)

struct XcdBarrier {
    unsigned* bar; unsigned x;
    volatile LAS unsigned* st;
};

__device__ __forceinline__ XcdBarrier xcd_barrier_post(unsigned* bar, volatile LAS unsigned* st) {
    XcdBarrier b; b.bar = bar; b.x = xb_xcc_id(); b.st = st;
    if (threadIdx.x == 0) (void)xb_add(&bar[XB_XCNT(b.x)], 1u);
    return b;
}
__device__ __forceinline__ void xcd_barrier_complete(unsigned* bar, unsigned x, unsigned& nloc, unsigned& nx) {
    const unsigned G = gridDim.x * gridDim.y * gridDim.z;
    unsigned sum, cnt, mine, sp = 0u;
    for (;;) {
        sum = 0u; cnt = 0u; mine = 0u;
#pragma unroll
        for (unsigned j = 0; j < 16; ++j) { const unsigned c = xb_ld(&bar[XB_XCNT(j)]); sum += c; cnt += (c > 0u) ? 1u : 0u; mine = (j == x) ? c : mine; }
        if (sum == G) break;
        __builtin_amdgcn_s_sleep(1);
        if ((++sp & 255u) == 0u) { if (xb_ld(&bar[XB_TMO])) break; if (sp > XB_SPIN_CAP) { atomicAdd(&bar[XB_TMO], 1u); break; } }
    }
    nloc = mine > 0u ? mine : 1u; nx = cnt > 0u ? cnt : 1u;
}

__device__ __forceinline__ void xcd_barrier(const XcdBarrier& b) {
    asm volatile("s_waitcnt vmcnt(0)" ::: "memory");
    __syncthreads();
    if (threadIdx.x == 0) {
        unsigned* bar = b.bar;
        __builtin_amdgcn_s_waitcnt(0);
        unsigned nloc = b.st[0], nx = b.st[1];
        if (nloc == 0u) { xcd_barrier_complete(bar, b.x, nloc, nx); b.st[0] = nloc; b.st[1] = nx; }
        const unsigned old = xb_add(&bar[XB_XSUB(b.x)], 1u);
        const unsigned gen = old / nloc;
        if (old + 1u == (gen + 1u) * nloc) {
            __builtin_amdgcn_fence(__ATOMIC_RELEASE, "agent");
            asm volatile("s_waitcnt vmcnt(0)" ::: "memory");
            const unsigned og = xb_add(&bar[XB_TOP], 1u);
            const unsigned tg = og / nx;
            if (og + 1u == (tg + 1u) * nx) xb_add(&bar[XB_TOPGEN], 1u);
            else XB_SPIN(xb_ld(&bar[XB_TOPGEN]) == tg, bar);
            __builtin_amdgcn_fence(__ATOMIC_ACQUIRE, "agent");
            xb_add(&bar[XB_XGEN(b.x)], 1u);
            asm volatile("s_waitcnt vmcnt(0)" ::: "memory");
        } else {
            XB_SPIN(xb_ld(&bar[XB_XGEN(b.x)]) == gen, bar);
            __builtin_amdgcn_fence(__ATOMIC_ACQUIRE, "agent");
            asm volatile("s_waitcnt vmcnt(0)" ::: "memory");
        }
    }
    __syncthreads();
}
namespace att {
constexpr float SCALE = 0.08838834764831845f, LOG2E = 1.4426950408889634f, LN2 = 0.6931471805599453f;
#define KSWZ(row, colB) ((row) * 256 + ((colB) ^ (((row) & 7) << 4)))
#define MFMA32(a, b, c) __builtin_amdgcn_mfma_f32_32x32x16_bf16((a), (b), (c), 0, 0, 0)
__device__ __forceinline__ int crow(int r, int hi) { return (r & 3) + 8 * (r >> 2) + 4 * hi; }
__device__ __forceinline__ int v_st(int k, int c) { const int kk = (k & ~0xC) | ((k & 4) << 1) | ((k & 8) >> 1); return ((kk >> 3) * 4 + (c >> 5)) * 512 + ((kk & 7) * 32 + (c & 31)) * 2; }
__device__ __forceinline__ int v_rd_base(int lane) { return ((lane & 3) << 3) | (((lane >> 2) & 3) << 6) | (((lane >> 4) & 1) << 5) | (((lane >> 5) & 1) << 8); }
__device__ __forceinline__ constexpr int v_rd_off(int d0, int ks, int half) { return d0 * 512 + ks * 4096 + half * 2048; }
typedef short v4i16_t __attribute__((ext_vector_type(4)));
__device__ __forceinline__ s16x4 tr_read(const LAS char* p) { return __builtin_bit_cast(s16x4, __builtin_amdgcn_ds_read_tr16_b64_v4i16((LAS v4i16_t*)p)); }
__device__ __forceinline__ float swap_max(float x) { auto rr = __builtin_amdgcn_permlane32_swap(__float_as_uint(x), __float_as_uint(x), false, false); return fmaxf(__uint_as_float(rr[0]), __uint_as_float(rr[1])); }
__device__ __forceinline__ float swap_add(float x) { auto rr = __builtin_amdgcn_permlane32_swap(__float_as_uint(x), __float_as_uint(x), false, false); return __uint_as_float(rr[0]) + __uint_as_float(rr[1]); }

__device__ __forceinline__ f32x16 zero16() { float z = 0.f; asm volatile("" : "+v"(z)); f32x16 r;
#pragma unroll
    for (int i = 0; i < 16; ++i) r[i] = z;
    return r; }
enum { M_A = 0, M_B = 1, M_C = 2, M_SLC = 3, M_WIN = 4, M_CMP = 5 };
constexpr int ATT_LDS_V = 0, ATT_LDS_K = 16384  , ATT_LDS_WS = 65536, ATT_LDS_CB = 65536 + 2048  , ATT_LDS_END = 65536 + 2048 + 512;

struct AttnP {
    const bf16* Q; const bf16* K; const bf16* V; bf16* O; float* LSE;
    const float* cum;
    const unsigned* bm;
    int q_pitch, kv_pitch, o_pitch, lse_pitch;
    int q_tok0, q_tstride, q_sub0;
    int k_tok0, k_tstride;
    int j_lo, j_hi;
};

template <int MODE, bool GQA>
__device__ __forceinline__ void attn_unit(const AttnP& p, LAS char* lds) {
    int tid_ = threadIdx.x; asm volatile("" : "+v"(tid_));
    const int tid = tid_, lane = tid & 63, r32 = lane & 31, hi = lane >> 5;
    const int wid = __builtin_amdgcn_readfirstlane(tid >> 6);
    constexpr int Q_PITCH = NP, O_PITCH = 512, LSE_PITCH = 4, KV_PITCH = (MODE == M_CMP) ? 128 : NP;
    const int q_tstride = (MODE == M_A) ? p.q_tstride : 1, k_tok0 = (MODE == M_A) ? p.k_tok0 : 0, k_tstride = (MODE == M_A) ? p.k_tstride : 1, q_sub0 = (MODE == M_A) ? p.q_sub0 : p.q_tok0;
    LAS float* wsc = (LAS float*)(lds + ATT_LDS_WS) + wid * 64;
    LAS float* cb = (LAS float*)(lds + ATT_LDS_CB);
    const int rowbase = GQA ? (wid >> 2) * 32 : wid * 32;
    const int rho = rowbase + r32;
    const int hcol = GQA ? (wid & 3) * 128 : 0;
    const int qtok = p.q_tok0 + rho * q_tstride;
    const int qsub = q_sub0 + rho;
    const int qmin = q_sub0 + rowbase, qmax = qmin + 31;
    constexpr float CEXP = (MODE == M_B) ? LOG2E : SCALE * LOG2E;
    bf16x8 qr[8];
    { const bf16* Qw = p.Q + (size_t)qtok * Q_PITCH + hcol + hi * 8;
#pragma unroll
      for (int d0 = 0; d0 < 8; ++d0) qr[d0] = *(const bf16x8*)(Qw + d0 * 16); }
    float m_reg = -1e30f, l_reg = 0.f; f32x16 o[4];
#pragma unroll
    for (int d = 0; d < 4; ++d) o[d] = zero16();
    const int sr = tid >> 4, sc = (tid & 15) * 8;
    const int vst0 = v_st(sr, sc), vst1 = v_st(32 + sr, sc), kst0 = KSWZ(sr, sc * 2), kst1 = KSWZ(32 + sr, sc * 2);
    const int vrb = v_rd_base(lane);
    struct Stage { bf16x8 vs0, vs1, ks0, ks1; float cpre; unsigned long long bmw; }; Stage sA, sB; sA.cpre = 0.f; sB.cpre = 0.f; sA.bmw = 0ull; sB.bmw = 0ull; unsigned long long bmw = 0ull;
    unsigned sel0 = 0u, sel1 = 0u, sel2 = 0u, sel3 = 0u; float cref = 0.f;
    if (MODE == M_SLC) { const v4u s4 = *(const v4u*)(p.bm + (size_t)qtok * 4); sel0 = s4.x; sel1 = s4.y; sel2 = s4.z; sel3 = s4.w; }
    if (MODE == M_B) cref = p.cum[p.q_tok0];
#define ATT_LOADT(ST, j) do { const int kk0_ = 64 * (j) + sr; const size_t t0_ = (size_t)(k_tok0 + kk0_ * k_tstride) * KV_PITCH + sc, t1_ = (size_t)(k_tok0 + (kk0_ + 32) * k_tstride) * KV_PITCH + sc; \
        ST.ks0 = *(const bf16x8*)(p.K + t0_); ST.ks1 = *(const bf16x8*)(p.K + t1_); ST.vs0 = *(const bf16x8*)(p.V + t0_); ST.vs1 = *(const bf16x8*)(p.V + t1_); \
        if (MODE == M_B) { if (tid < 64) ST.cpre = cref - p.cum[64 * (j) + tid]; } \
        if (MODE == M_C) ST.bmw = *(const unsigned long long*)(p.bm + (size_t)qtok * 256 + 2 * (j)); } while (0)
#define ATT_WRITET(ST, buf) do { LAS char* vl_ = lds + (buf) * 32768 + ATT_LDS_V; LAS char* kl_ = lds + (buf) * 32768 + ATT_LDS_K; \
        *(LAS bf16x8*)(vl_ + vst0) = ST.vs0; *(LAS bf16x8*)(vl_ + vst1) = ST.vs1; *(LAS bf16x8*)(kl_ + kst0) = ST.ks0; *(LAS bf16x8*)(kl_ + kst1) = ST.ks1; \
        if (MODE == M_B) { if (tid < 64) cb[(buf) * 64 + tid] = ST.cpre; } \
        if (MODE == M_C) bmw = ST.bmw; } while (0)
    if (p.j_lo < p.j_hi) {
        ATT_LOADT(sA, p.j_lo);
        __syncthreads();
        ATT_WRITET(sA, 0);
        if (p.j_lo + 1 < p.j_hi) ATT_LOADT(sA, p.j_lo + 1);
        if (p.j_lo + 2 < p.j_hi) ATT_LOADT(sB, p.j_lo + 2);
        __syncthreads();
        for (int j0 = p.j_lo; j0 < p.j_hi; j0 += 2)
#pragma unroll
        for (int half = 0; half < 2; ++half) { const int j = j0 + half; const int buf = half; if (j >= p.j_hi) break;
            const LAS char* K_lds = lds + buf * 32768 + ATT_LDS_K; const LAS char* vb0 = lds + buf * 32768 + ATT_LDS_V + vrb;
            f32x16 p0, p1;
#pragma unroll
            for (int d0 = 0; d0 < 8; ++d0) { const int cbt = (d0 * 16 + hi * 8) * 2;
                const bf16x8 b0 = *(const LAS bf16x8*)(K_lds + KSWZ(r32, cbt)); const bf16x8 b1 = *(const LAS bf16x8*)(K_lds + KSWZ(32 + r32, cbt));
                if (d0 == 0) { const f32x16 z16 = {0.f, 0.f, 0.f, 0.f, 0.f, 0.f, 0.f, 0.f, 0.f, 0.f, 0.f, 0.f, 0.f, 0.f, 0.f, 0.f}; p0 = MFMA32(b0, qr[0], z16); p1 = MFMA32(b1, qr[0], z16); }
                else { p0 = MFMA32(b0, qr[d0], p0); p1 = MFMA32(b1, qr[d0], p1); } }
            {
                const float NINF = -__builtin_inff();
                bool interior;
                if (MODE == M_A)        interior = 64 * j + 63 <= qmin && qmax - 64 * j <= 128;
                else if (MODE == M_B)   interior = 64 * j + 63 <= qmin;
                else if (MODE == M_SLC) interior = 64 * j + 63 <= qmin;
                else if (MODE == M_WIN) interior = 64 * j + 63 <= qmin && qmax - 64 * j < 512;
                else if (MODE == M_CMP) interior = 16 * (64 * j + 63) + 31 <= qmin;
                else                    interior = false;
                bool selb = true;
                if (MODE == M_SLC) { const unsigned sw = j < 32 ? sel0 : (j < 64 ? sel1 : (j < 96 ? sel2 : sel3)); selb = ((sw >> (j & 31)) & 1u) != 0u; }
                if (interior) {
                    if (MODE == M_B) {
#pragma unroll
                        for (int g = 0; g < 4; ++g) { const f32x4 bia0 = *(const LAS f32x4*)(cb + buf * 64 + 8 * g + 4 * hi), bia1 = *(const LAS f32x4*)(cb + buf * 64 + 32 + 8 * g + 4 * hi);
#pragma unroll
                            for (int i = 0; i < 4; ++i) { p0[4 * g + i] = fmaf(p0[4 * g + i], SCALE, bia0[i]); p1[4 * g + i] = fmaf(p1[4 * g + i], SCALE, bia1[i]); } }
                    } else if (MODE == M_SLC) {
#pragma unroll
                        for (int r = 0; r < 16; ++r) { p0[r] = selb ? p0[r] : NINF; p1[r] = selb ? p1[r] : NINF; }
                    }
                } else {
                    int dq = qsub - 64 * j - 4 * hi;
                    asm volatile("" : "+v"(dq));
                    int lim = 0; unsigned w0 = 0u, w1 = 0u;
                    if (MODE == M_CMP) { lim = ((qsub - 31) >> 4) - 64 * j - 4 * hi; asm volatile("" : "+v"(lim)); }
                    if (MODE == M_C) { w0 = (unsigned)bmw >> (4 * hi); w1 = (unsigned)(bmw >> 32) >> (4 * hi); }
#pragma unroll
                    for (int g = 0; g < 4; ++g) {
                        f32x4 bia0 = {0.f, 0.f, 0.f, 0.f}, bia1 = {0.f, 0.f, 0.f, 0.f};
                        if (MODE == M_B) { bia0 = *(const LAS f32x4*)(cb + buf * 64 + 8 * g + 4 * hi); bia1 = *(const LAS f32x4*)(cb + buf * 64 + 32 + 8 * g + 4 * hi); }
#pragma unroll
                        for (int i = 0; i < 4; ++i) { const int r = 4 * g + i, base = i + 8 * g;
                            bool v0, v1;
                            if (MODE == M_A)        { v0 = (unsigned)(dq - base) <= 128u; v1 = (unsigned)(dq - base - 32) <= 128u; }
                            else if (MODE == M_B)   { v0 = base <= dq; v1 = base + 32 <= dq; }
                            else if (MODE == M_C)   { v0 = ((w0 >> base) & 1u) != 0u; v1 = ((w1 >> base) & 1u) != 0u; }
                            else if (MODE == M_SLC) { v0 = selb && base <= dq; v1 = selb && base + 32 <= dq; }
                            else if (MODE == M_WIN) { v0 = (unsigned)(dq - base) < 512u; v1 = (unsigned)(dq - base - 32) < 512u; }
                            else                    { v0 = base <= lim; v1 = base + 32 <= lim; }
                            if (MODE == M_B) { p0[r] = v0 ? fmaf(p0[r], SCALE, bia0[i]) : NINF; p1[r] = v1 ? fmaf(p1[r], SCALE, bia1[i]) : NINF; }
                            else             { p0[r] = v0 ? p0[r] : NINF; p1[r] = v1 ? p1[r] : NINF; } }
                    }
                }
            }
            float pmax = p0[0];
#pragma unroll
            for (int r = 1; r < 16; ++r) pmax = fmaxf(pmax, p0[r]);
#pragma unroll
            for (int r = 0; r < 16; ++r) pmax = fmaxf(pmax, p1[r]);
            pmax = swap_max(pmax);
            const float mn = fmaxf(m_reg, pmax); const float alpha = __builtin_amdgcn_exp2f((m_reg - mn) * CEXP); m_reg = mn;
            const float mnC = -mn * CEXP;
#pragma unroll
            for (int r = 0; r < 16; ++r) { p0[r] = __builtin_amdgcn_exp2f(fmaf(p0[r], CEXP, mnC)); p1[r] = __builtin_amdgcn_exp2f(fmaf(p1[r], CEXP, mnC)); }
            float ps = 0.f;
#pragma unroll
            for (int r = 0; r < 16; ++r) ps += p0[r] + p1[r];
            ps = swap_add(ps);
            l_reg = l_reg * alpha + ps;
            if (__any(alpha < 1.f)) {
                if (hi == 0) wsc[r32] = alpha;
                LDS_WAIT();
#pragma unroll
                for (int r = 0; r < 16; ++r) { const float a = wsc[crow(r, hi)];
#pragma unroll
                    for (int d = 0; d < 4; ++d) o[d][r] *= a; }
            }
            bf16x8 pa0, pa1, pa2, pa3;
#define ATT_PK4(P, BASE, OUT) do { unsigned a0 = cvtpk(P[BASE + 0], P[BASE + 1]), a1 = cvtpk(P[BASE + 2], P[BASE + 3]); \
                unsigned b0_ = cvtpk(P[BASE + 4], P[BASE + 5]), b1_ = cvtpk(P[BASE + 6], P[BASE + 7]); \
                auto r0 = __builtin_amdgcn_permlane32_swap(a0, b0_, false, false); auto r1 = __builtin_amdgcn_permlane32_swap(a1, b1_, false, false); \
                v4u w = {r0[0], r1[0], r0[1], r1[1]}; OUT = __builtin_bit_cast(bf16x8, w); } while (0)
            ATT_PK4(p0, 0, pa0); ATT_PK4(p0, 8, pa1); ATT_PK4(p1, 0, pa2); ATT_PK4(p1, 8, pa3);
#define ATT_PKV(L, H) (bf16x8){L[0], L[1], L[2], L[3], H[0], H[1], H[2], H[3]}
#pragma unroll
            for (int d0 = 0; d0 < 4; ++d0) {
                const s16x4 l0 = tr_read(vb0 + v_rd_off(d0, 0, 0)), h0 = tr_read(vb0 + v_rd_off(d0, 0, 1)), l1 = tr_read(vb0 + v_rd_off(d0, 1, 0)), h1 = tr_read(vb0 + v_rd_off(d0, 1, 1));
                const s16x4 l2 = tr_read(vb0 + v_rd_off(d0, 2, 0)), h2 = tr_read(vb0 + v_rd_off(d0, 2, 1)), l3 = tr_read(vb0 + v_rd_off(d0, 3, 0)), h3 = tr_read(vb0 + v_rd_off(d0, 3, 1));
                o[d0] = MFMA32(pa0, ATT_PKV(l0, h0), o[d0]); o[d0] = MFMA32(pa1, ATT_PKV(l1, h1), o[d0]);
                o[d0] = MFMA32(pa2, ATT_PKV(l2, h2), o[d0]); o[d0] = MFMA32(pa3, ATT_PKV(l3, h3), o[d0]);
            }
            if (half == 0) { if (j + 1 < p.j_hi) { ATT_WRITET(sA, 1); } __syncthreads(); if (j + 3 < p.j_hi) ATT_LOADT(sA, j + 3); }
            else           { if (j + 1 < p.j_hi) { ATT_WRITET(sB, 0); } __syncthreads(); if (j + 3 < p.j_hi) ATT_LOADT(sB, j + 3); }
        }
    }
#undef ATT_LOADT
#undef ATT_WRITET
    if (hi == 0) wsc[32 + r32] = l_reg;
    if (p.LSE != nullptr && hi == 0) p.LSE[(size_t)qtok * LSE_PITCH + (GQA ? (wid & 3) : 0)] = l_reg > 0.f ? m_reg * (MODE == M_B ? 1.f : SCALE) + __builtin_amdgcn_logf(l_reg) * LN2 : -1e30f;
    LDS_WAIT();
#pragma unroll
    for (int r = 0; r < 16; ++r) { const int rr = crow(r, hi); const float lv = wsc[32 + rr]; const float rl = lv > 0.f ? 1.f / lv : 0.f;
        bf16* orow = p.O + (size_t)(p.q_tok0 + (rowbase + rr) * q_tstride) * O_PITCH + hcol + r32;
#pragma unroll
        for (int d0 = 0; d0 < 4; ++d0) orow[d0 * 32] = (bf16)f2bf(o[d0][r] * rl); }
}

__device__ __forceinline__ void idx_unit(const bf16* P, float* SC, int qb, int kc, LAS char* lds, unsigned long long* tsx = nullptr) {
    int tid_ = threadIdx.x; asm volatile("" : "+v"(tid_));
    const int tid = tid_, lane = tid & 63, r32 = lane & 31, hi = lane >> 5;
    const int wid = __builtin_amdgcn_readfirstlane(tid >> 6);
    bf16x8 kf[4][4];
    { const bf16* kp = P + (size_t)(128 * kc + r32) * NP + COL_MISC + MI_CKI + hi * 8;
#pragma unroll
      for (int s = 0; s < 4; ++s)
#pragma unroll
          for (int ks = 0; ks < 4; ++ks) kf[s][ks] = *(const bf16x8*)(kp + (size_t)(32 * s) * NP + ks * 16); }
    unsigned long long tA_ = 0, tB_ = 0; if (tsx) { asm volatile("s_waitcnt vmcnt(0)" ::: "memory"); tA_ = __builtin_amdgcn_s_memrealtime(); }
    const int t = 256 * qb + wid * 32 + r32;
    f32x16 acc[4];
#pragma unroll
    for (int s = 0; s < 4; ++s) acc[s] = zero16();
    const bf16* qrow = P + (size_t)t * NP + COL_CQI + hi * 8;
    const bf16* wrow = P + (size_t)t * NP + COL_MISC + MI_CWI;
#pragma unroll 1
    for (int g = 0; g < 4; ++g) {
        bf16x8 qg[4][4];
#pragma unroll
        for (int hh = 0; hh < 4; ++hh) {
#pragma unroll
            for (int ks = 0; ks < 4; ++ks) qg[hh][ks] = *(const bf16x8*)(qrow + (4 * g + hh) * 64 + ks * 16); }
        const v2u wpk = *(const v2u*)(wrow + 4 * g);
#pragma unroll
        for (int hh = 0; hh < 4; ++hh) {
#pragma unroll
            for (int sp = 0; sp < 2; ++sp) {
                const f32x16 z16 = {0.f, 0.f, 0.f, 0.f, 0.f, 0.f, 0.f, 0.f, 0.f, 0.f, 0.f, 0.f, 0.f, 0.f, 0.f, 0.f};
                f32x16 pa = MFMA32(kf[2 * sp][0], qg[hh][0], z16), pb = MFMA32(kf[2 * sp + 1][0], qg[hh][0], z16);
#pragma unroll
                for (int ks = 1; ks < 4; ++ks) { pa = MFMA32(kf[2 * sp][ks], qg[hh][ks], pa); pb = MFMA32(kf[2 * sp + 1][ks], qg[hh][ks], pb); }
                typedef float f32x2_ __attribute__((ext_vector_type(2)));
                const unsigned wbits = hh < 2 ? wpk.x : wpk.y; const float wh = ((hh & 1) ? bfhi(wbits) : bflo(wbits)) * 0.03125f;
                const f32x2_ w2 = {wh, wh};
#pragma unroll
                for (int r = 0; r < 16; r += 2) {
                    const f32x2_ ra = {__builtin_amdgcn_fmed3f(pa[r], 0.f, __builtin_inff()), __builtin_amdgcn_fmed3f(pa[r + 1], 0.f, __builtin_inff())};
                    const f32x2_ rb = {__builtin_amdgcn_fmed3f(pb[r], 0.f, __builtin_inff()), __builtin_amdgcn_fmed3f(pb[r + 1], 0.f, __builtin_inff())};
                    const f32x2_ a2 = {acc[2 * sp][r], acc[2 * sp][r + 1]}, b2 = {acc[2 * sp + 1][r], acc[2 * sp + 1][r + 1]};
                    const f32x2_ oa = __builtin_elementwise_fma(w2, ra, a2), ob = __builtin_elementwise_fma(w2, rb, b2);
                    acc[2 * sp][r] = oa[0]; acc[2 * sp][r + 1] = oa[1]; acc[2 * sp + 1][r] = ob[0]; acc[2 * sp + 1][r + 1] = ob[1]; }
#ifndef IDX_NOSB
                __builtin_amdgcn_sched_barrier(0);
#endif
            }
        }
    }
    if (tsx) { tB_ = __builtin_amdgcn_s_memrealtime(); }
    LAS float* img = (LAS float*)(lds + wid * 16384);
#pragma unroll
    for (int s = 0; s < 4; ++s)
#pragma unroll
        for (int g = 0; g < 4; ++g) { const f32x4 v = {acc[s][4 * g], acc[s][4 * g + 1], acc[s][4 * g + 2], acc[s][4 * g + 3]}; *(LAS f32x4*)(img + r32 * 128 + 4 * ((8 * s + 2 * g + hi) ^ r32)) = v; }
    LDS_WAIT();
    const int pitch = 256 * (qb + 1) + 32;
    float* out = SC + (size_t)65536 * (qb * (qb + 1) / 2) + (size_t)8192 * qb + (size_t)(wid * 32) * pitch + 128 * kc;
#pragma unroll
    for (int i = 0; i < 16; ++i) { const int row = 2 * i + (lane >> 5), c4 = (lane & 31) * 4; const f32x4 v = *(const LAS f32x4*)(img + row * 128 + 4 * ((lane & 31) ^ row)); *(f32x4*)(out + (size_t)row * pitch + c4) = v; }
    if (tsx) { asm volatile("s_waitcnt vmcnt(0)" ::: "memory"); const unsigned long long tC_ = __builtin_amdgcn_s_memrealtime(); if (threadIdx.x == 0) { tsx[0] += tB_ - tA_; tsx[1] += tC_ - tB_; tsx[2] += 1ull; } }
}

__device__ __forceinline__ unsigned satsub(unsigned a, unsigned b) { unsigned r; asm("v_sub_u32_e64 %0, %1, %2 clamp" : "=v"(r) : "v"(a), "v"(b)); return r; }
__device__ __forceinline__ int wave_isum(int v) {
#pragma unroll
    for (int o = 1; o < 64; o <<= 1) v += __shfl_xor(v, o);
    return v;
}
template <int NCH> __device__ __forceinline__ int count_ge(const unsigned (&key)[NCH], unsigned cand) {
    int cnt = 0;
#pragma unroll
    for (int i = 0; i < NCH; i += 8) {
        unsigned long long m0, m1, m2, m3, m4, m5, m6, m7;
        asm volatile("v_cmp_ge_u32_e64 %0, %8, %16\n\tv_cmp_ge_u32_e64 %1, %9, %16\n\tv_cmp_ge_u32_e64 %2, %10, %16\n\tv_cmp_ge_u32_e64 %3, %11, %16\n\t"
                     "v_cmp_ge_u32_e64 %4, %12, %16\n\tv_cmp_ge_u32_e64 %5, %13, %16\n\tv_cmp_ge_u32_e64 %6, %14, %16\n\tv_cmp_ge_u32_e64 %7, %15, %16\n\ts_nop 1"
                     : "=s"(m0), "=s"(m1), "=s"(m2), "=s"(m3), "=s"(m4), "=s"(m5), "=s"(m6), "=s"(m7)
                     : "v"(key[i]), "v"(key[i + 1]), "v"(key[i + 2]), "v"(key[i + 3]), "v"(key[i + 4]), "v"(key[i + 5]), "v"(key[i + 6]), "v"(key[i + 7]), "v"(cand));
        cnt += __builtin_popcountll(m0) + __builtin_popcountll(m1) + __builtin_popcountll(m2) + __builtin_popcountll(m3)
             + __builtin_popcountll(m4) + __builtin_popcountll(m5) + __builtin_popcountll(m6) + __builtin_popcountll(m7);
    }
    return cnt;
}
#define WRL(dst, sval, ln) asm volatile("s_nop 3\n\tv_writelane_b32 %0, %1, %2\n\ts_nop 1" : "+v"(dst) : "s"(sval), "n"(ln))
template <int NCH>
__device__ __forceinline__ void select_row(const float* SC, unsigned* BM, int t, int lane_) {
    int lane = lane_; asm volatile("" : "+v"(lane));
    const int qb_ = t >> 8; const float* row = SC + (size_t)65536 * (qb_ * (qb_ + 1) / 2) + (size_t)8192 * qb_ + (size_t)(t & 255) * (256 * (qb_ + 1) + 32);
    unsigned key[NCH]; constexpr int SELB = NCH < 64 ? NCH : 64;
#pragma unroll
    for (int b = 0; b < NCH; b += SELB) {
#pragma unroll
        for (int i = b; i < b + SELB; ++i) key[i] = __float_as_uint(row[i * 64 + lane]);
#pragma unroll
        for (int i = b; i < b + SELB; ++i) { unsigned u = key[i]; u ^= ((unsigned)((int)u >> 31) | 0x80000000u); key[i] = (i * 64 + lane) <= t ? u : 0u; }
        asm volatile("" ::: "memory");
    }
    unsigned prefix = 1u; int cge = t + 1;
    if (t >= 256) {
        prefix = 0u;
#pragma unroll 1
        for (int bit = 31; bit >= 0; --bit) {
            const unsigned cand = prefix | (1u << bit); const int c = count_ge<NCH>(key, cand);
            if (c >= 256) { prefix = cand; cge = c; }
            if (c == 256) break;
        }
    }
    const int target = t >= 256 ? 256 : t + 1;
    unsigned m0l = 0u, m0h = 0u, m1l = 0u, m1h = 0u;
    if (cge == target) {
#pragma unroll
        for (int i = 0; i < NCH; ++i) { const unsigned long long b = __ballot(key[i] >= prefix);
            if (i < 64) { WRL(m0l, (unsigned)b, i & 63); WRL(m0h, (unsigned)(b >> 32), i & 63); }
            else { WRL(m1l, (unsigned)b, i & 63); WRL(m1h, (unsigned)(b >> 32), i & 63); }
            __builtin_amdgcn_sched_barrier(0); }
    } else {
        int cgt = 0;
#pragma unroll
        for (int i = 0; i < NCH; ++i) cgt += (int)min(satsub(key[i], prefix), 1u);
        cgt = wave_isum(cgt);
        const int need = target - cgt; int run = 0; const unsigned long long lt = (1ull << lane) - 1ull;
#pragma unroll
        for (int i = 0; i < NCH; ++i) {
            const bool eq = key[i] == prefix; const unsigned long long beq = __ballot(eq);
            const bool selk = key[i] > prefix || (eq && (run + (int)__popcll(beq & lt)) < need);
            run += (int)__popcll(beq);
            const unsigned long long b = __ballot(selk);
            if (i < 64) { WRL(m0l, (unsigned)b, i & 63); WRL(m0h, (unsigned)(b >> 32), i & 63); }
            else { WRL(m1l, (unsigned)b, i & 63); WRL(m1h, (unsigned)(b >> 32), i & 63); }
            __builtin_amdgcn_sched_barrier(0);
        }
    }
    const int nwords = 8 * ((t >> 8) + 1);
    unsigned* brow = BM + (size_t)t * 256;
    if (2 * lane < nwords && lane < NCH) { const v2u o = {m0l, m0h}; *(v2u*)(brow + 2 * lane) = o; }
    if (NCH > 64) { if (128 + 2 * lane < nwords) { const v2u o = {m1l, m1h}; *(v2u*)(brow + 128 + 2 * lane) = o; } }
}
}
__device__ __forceinline__ int next_unit(unsigned* ctr, LAS char* lds) {
    LAS int* slot = (LAS int*)(lds + 131072);
    __syncthreads();
    if (threadIdx.x == 0) *slot = (int)__hip_atomic_fetch_add(ctr, 1u, __ATOMIC_RELAXED, __HIP_MEMORY_SCOPE_AGENT);
    __syncthreads();
    return *slot;
}
namespace att {
__device__ __forceinline__ int b_skip(const float* cum, int t0, int nt, const float* q2p, const float* k2p, int nwv, LAS char* lds) {
    LAS int* slot = (LAS int*)(lds + 131072 + 16);
    int tid = threadIdx.x; asm volatile("" : "+v"(tid));
    if (tid < 64) { float k2 = 0.f;
#pragma unroll
        for (int i = 0; i < 32; ++i) { const int wv = i * 64 + tid; if (wv < nwv) k2 = fmaxf(k2, k2p[wv]); }
#pragma unroll
        for (int o = 1; o < 64; o <<= 1) k2 = fmaxf(k2, __shfl_xor(k2, o));
        float q2 = fmaxf(fmaxf(q2p[tid], q2p[64 + tid]), fmaxf(q2p[128 + tid], q2p[192 + tid]));
#pragma unroll
        for (int o = 1; o < 64; o <<= 1) q2 = fmaxf(q2, __shfl_xor(q2, o));
        const float bound = 2.f * SCALE * sqrtf(q2) * sqrtf(k2) + 32.f;
        const float c0 = cum[t0]; const int j0 = tid, j1 = tid + 64;
        const bool ok0 = j0 < nt && (cum[64 * j0 + 63] - c0) <= bound, ok1 = j1 < nt && (cum[64 * j1 + 63] - c0) <= bound;
        const unsigned long long m0 = __ballot(ok0), m1 = __ballot(ok1);
        const int r = m0 ? (int)__builtin_ctzll(m0) : (m1 ? 64 + (int)__builtin_ctzll(m1) : nt);
        if (tid == 0) *slot = r; }
    __syncthreads();
    return *slot;
}
__device__ __forceinline__ void write_empty_lse(float* LSE, int t0, int pitch) { const int tid = threadIdx.x; if (tid < 256) LSE[(size_t)(t0 + tid) * pitch] = -1e30f; }
}
constexpr size_t MiB = 1u << 20;
#ifdef HYB_TIME
constexpr size_t WS_CTL = 0, CTL_ZERO_BYTES = 1 * MiB;
#else
constexpr size_t WS_CTL = 0, CTL_ZERO_BYTES = 64 * 1024;
#endif
constexpr size_t WS_TAB = 1 * MiB, WS_TABI = 5 * MiB, WS_OVM = 7 * MiB, WS_KI = 8 * MiB, WS_CUM = 9 * MiB, WS_NRM = 9 * MiB + 128 * 1024  , WS_KVC = 9 * MiB + 512 * 1024, WS_HID = 10 * MiB, WS_SEL = 11 * MiB;
constexpr size_t WS_LSEA = 12 * MiB, WS_LSEB = 12 * MiB + 512 * 1024, WS_LSEC = 13 * MiB + 128 * 1024, WS_LSES = 35 * MiB;
constexpr size_t WS_CA = 14 * MiB, WS_BM = 22 * MiB, WS_W2T = 30 * MiB, WS_W1T = 31 * MiB, WS_HIDP = 36 * MiB  , WS_XN = 40 * MiB, WS_X2 = 72 * MiB;
constexpr size_t WS_RA = 136 * MiB, WS_P = WS_RA, WS_Y = WS_RA, WS_WFI = WS_RA, WS_WFO = WS_RA + 44 * MiB;
constexpr size_t WS_RB = 296 * MiB, WS_OA = WS_RB, WS_PB = WS_OA + 24 * MiB, WS_PC = WS_PB + 36 * MiB, WS_PS = WS_PC + 36 * MiB, WS_OCMP = WS_PS + 36 * MiB, WS_OWIN = WS_OCMP + 8 * MiB, WS_IMPH = WS_OWIN + 8 * MiB;
constexpr size_t WS_MG = WS_RB, WS_ACT = WS_RB + 32 * MiB;
constexpr size_t WS_RC = 456 * MiB, WS_WIN = WS_RC, WS_SC = WS_RC, WS_WG = WS_RC, WS_WB = WS_RC + 32 * MiB, WS_WO = WS_RC + 40 * MiB;
constexpr size_t WS_BR = WS_RC + 64 * MiB, WS_END = 589 * MiB;
static_assert(WS_IMPH + 8 * MiB <= WS_RC && WS_ACT + 88 * MiB <= WS_RC && WS_WFO + 22 * MiB <= WS_RB, "ws map");
constexpr int CW_BAR = 4096, CW_QUEUE = 8192, CW_NORM = 12288;
constexpr int RING_BYTES = 131072, LDSCTL_OFF = RING_BYTES, MISC_OFF = LDSCTL_OFF + 320, LDS_BYTES = 147456;
constexpr int NWAVES = 8;
struct Frame { LAS unsigned char* lds; int tid, lane, wave, G, gw, NGW; };
__device__ __forceinline__ void mkframe(Frame& F, unsigned char* lds_raw, int grid) { int t = threadIdx.x; asm volatile("" : "+v"(t)); F.lds = (LAS unsigned char*)lds_raw; F.tid = t; F.lane = t & 63; F.wave = __builtin_amdgcn_readfirstlane(t >> 6);
    F.G = grid; F.gw = blockIdx.x * NWAVES + F.wave; F.NGW = F.G * NWAVES; }
enum { MAP_ID = 0, MAP_IN = 1, MAP_GATE = 2, MAP_FFI = 3, MAP_W2 = 4, MAP_W2P = 5 };
template <int MAP> __device__ __forceinline__ int src_col(int n) {
    if (MAP == MAP_IN) {
        const int p7 = n & 127, d128 = 4 * (p7 >> 3) + ((p7 >> 1) & 3) + 64 * (p7 & 1), hb = n & ~127;
        const int p6 = n & 63, d64 = 4 * (p6 >> 3) + ((p6 >> 1) & 3) + 32 * (p6 & 1), hb64 = n & ~63;
        if (n < 3072) return hb + d128;
        if (n < 6144) return n;
        if (n < 7168) return hb + 4 + d128;
        if (n < 7680) return n + 4;
        if (n < 8704) return hb64 + 4 + d64;
        if (n < 9216) return hb + 84 + d128;
        if (n < 9984) return (((n - 9216) >> 7) & 1) ? n + 84 : hb + 84 + d128;
        if (n < 10048) return 8708 + d64;
        if (n < 10052) return 6144 + (n - 10048);
        if (n < 10068) return 8772 + (n - 10052);
        if (n < 10080) return n;
        return -1;
    } else if (MAP == MAP_GATE) {
        const int pn = n >> 8, c = n & 255, bj = c >> 7, wc = (c >> 5) & 3, fq = (c >> 3) & 3, nn = (c >> 2) & 1, i = c & 3;
        return (2 * bj + nn) * DM + 64 * pn + 16 * wc + 4 * fq + i;
    } else if (MAP == MAP_FFI) {
        const int pn = n >> 8, c = n & 255; return ((c >> 7) ? NFF : 0) + 128 * pn + (c & 127);
    } else if (MAP == MAP_W2) {
        return n < 128 ? n : -1;
    } else if (MAP == MAP_W2P) {
        return n < 128 ? 4 * (n >> 3) + ((n >> 1) & 3) + 64 * (n & 1) : -1;
    } else return n;
}
template <int MAP> __device__ __forceinline__ void transpose_item(const float* W, int K, int Nsrc, int Ndst, bf16* WT, LAS float* scr, int item, int lane) {
    const int nblk = Ndst / 32, kb = item / nblk, nb = item % nblk, k0 = 64 * kb, n0 = 32 * nb;
    const int sc = src_col<MAP>(n0 + (lane & 31));
    float v[32];
    const float* wp = W + (size_t)(k0 + (lane >> 5)) * Nsrc + (sc >= 0 ? sc : 0);
#pragma unroll
    for (int i = 0; i < 32; ++i) v[i] = __builtin_nontemporal_load(wp + (size_t)(2 * i) * Nsrc);
#pragma unroll
    for (int i = 0; i < 32; ++i) scr[(2 * i + (lane >> 5)) * 33 + (lane & 31)] = sc >= 0 ? v[i] : 0.f;
    LDS_WAIT(); asm volatile("" ::: "memory");
    const int c = lane & 7;
#pragma unroll
    for (int j = 0; j < 4; ++j) { const int n = (lane >> 3) + 8 * j; const LAS float* s = scr + (8 * c) * 33 + n;
        v4u o; o.x = pk2(s[0 * 33], s[1 * 33]); o.y = pk2(s[2 * 33], s[3 * 33]); o.z = pk2(s[4 * 33], s[5 * 33]); o.w = pk2(s[6 * 33], s[7 * 33]);
        *(v4u*)(WT + (size_t)(n0 + n) * K + k0 + 8 * c) = o; }
    LDS_WAIT(); asm volatile("" ::: "memory");
}
template <int MAP> __device__ __forceinline__ void transpose_all(const Frame& F, const float* W, int K, int Nsrc, int Ndst, bf16* WT) {
    LAS float* scr = (LAS float*)(F.lds + F.wave * 16384);
    const int nitems = (K / 64) * (Ndst / 32);
    for (int it = F.gw; it < nitems; it += F.NGW) transpose_item<MAP>(W, K, Nsrc, Ndst, WT, scr, it, F.lane);
}
template <int MAP> __device__ __forceinline__ void transpose_some(const Frame& F, int gw, int ngw, const float* W, int K, int Nsrc, int Ndst, bf16* WT) {
    LAS float* scr = (LAS float*)(F.lds + F.wave * 16384);
    const int nitems = (K / 64) * (Ndst / 32);
    for (int it = gw; it < nitems; it += ngw) transpose_item<MAP>(W, K, Nsrc, Ndst, WT, scr, it, F.lane);
}
__device__ __forceinline__ void rms_row(const float* xrow, const float* g, bf16* obf, float* of32, int lane) {
    const f32x4* xr = (const f32x4*)xrow + lane; const f32x4* gr = (const f32x4*)g + lane;
    f32x4 v[8]; float s = 0.f;
#pragma unroll
    for (int j = 0; j < 8; ++j) { v[j] = xr[64 * j]; s += (v[j].x * v[j].x + v[j].y * v[j].y) + (v[j].z * v[j].z + v[j].w * v[j].w); }
    const float r = 1.0f / sqrtf(wave_sum(s) * (1.f / DM) + 1e-6f);
#pragma unroll
    for (int j = 0; j < 8; ++j) { const f32x4 gv = gr[64 * j]; const f32x4 y = {v[j].x * r * gv.x, v[j].y * r * gv.y, v[j].z * r * gv.z, v[j].w * r * gv.w};
        if (obf) { v2u o; o.x = pk2(y.x, y.y); o.y = pk2(y.z, y.w); *((v2u*)obf + lane + 64 * j) = o; }
        else *((f32x4*)of32 + lane + 64 * j) = y; }
}
__device__ __forceinline__ float2 cossin_d(float angf) {
    const double x = (double)angf; const double k = rint(x * 0.6366197723675814);
    double r = fma(-k, 1.5707963267948966, x); r = fma(-k, 6.123233995736766e-17, r);
    const int q = (int)k & 3; const double r2 = r * r;
    const double sn = r * (1.0 + r2 * (-1.0 / 6 + r2 * (1.0 / 120 + r2 * (-1.0 / 5040 + r2 * (1.0 / 362880 + r2 * (-1.0 / 39916800 + r2 * (1.0 / 6227020800.0)))))));
    const double cn = 1.0 + r2 * (-0.5 + r2 * (1.0 / 24 + r2 * (-1.0 / 720 + r2 * (1.0 / 40320 + r2 * (-1.0 / 3628800 + r2 * (1.0 / 479001600 + r2 * (-1.0 / 87178291200.0)))))));
    const double c = (q == 0) ? cn : (q == 1) ? -sn : (q == 2) ? -cn : sn;
    const double s_ = (q == 0) ? sn : (q == 1) ? cn : (q == 2) ? -sn : -cn;
    return make_float2((float)c, (float)s_);
}
__device__ __forceinline__ void build_tables(const Frame& F, float2* TAB, float2* TABI, bf16* OVM) {
    const int gt = F.gw * 64 + F.lane, NT = F.NGW * 64;
    for (int i = gt; i < S * 64; i += NT) { const int t = i >> 6, d = i & 63;
        double f = 1.0; for (int k = 0; k < d; ++k) f *= 0.8659643233600653523;
        TAB[i] = cossin_d((float)t * (float)f); }
    for (int i = gt; i < S * 32; i += NT) { const int t = i >> 5, d = i & 31;
        double f = 1.0; for (int k = 0; k < d; ++k) f *= 0.7498942093324558273;
        TABI[i] = cossin_d((float)t * (float)f); }
    for (int i = gt; i < 512 * 128; i += NT) { const int n = i >> 7, j = i & 127; OVM[i] = (n < 511 && n >= 4 * j - 1 && n <= 4 * j + 3) ? (bf16)0x3F80 : (bf16)0; }
}
__device__ __forceinline__ void prep_phase(const Frame& F, const bf16* P, bf16* CA, float* CUM, float* NRM, const float* pe, const float* bf_) {
    const int lane = F.lane;
    const int p1 = 8 * (lane >> 2) + 2 * (lane & 3);
    for (int it = F.gw; it < 1024; it += F.NGW) { const int kv = it >> 9, n = it & 511; bf16* dst = CA + (size_t)it * 4096;
        for (int i = 0; i < 32; ++i) { float y1 = 0.f, y2 = 0.f;
            if (n < 511) { const int t = 16 * n + i; const bf16* b = P + (size_t)t * NP + (kv ? COL_DVC : COL_DKC);
                if (kv == 0) { y1 = bf2f(b[p1]); y2 = bf2f(b[p1 + 1]); } else { y1 = bf2f(b[lane]); y2 = bf2f(b[64 + lane]); }
                y1 += pe[(kv * 32 + i) * 128 + lane]; y2 += pe[(kv * 32 + i) * 128 + 64 + lane]; }
            dst[i * 128 + lane] = (bf16)f2bf(y1); dst[i * 128 + 64 + lane] = (bf16)f2bf(y2); } }
    { float kmax[4] = {0.f, 0.f, 0.f, 0.f};
      for (int t = F.gw; t < S; t += F.NGW) { const bf16* row = P + (size_t)t * NP;
#pragma unroll
        for (int h = 0; h < 4; ++h) { const unsigned qv = *(const unsigned*)(row + COL_BQ + h * 128 + 2 * lane), kv = *(const unsigned*)(row + COL_BK + h * 128 + 2 * lane);
            const float q2 = wave_sum(bflo(qv) * bflo(qv) + bfhi(qv) * bfhi(qv)), k2 = wave_sum(bflo(kv) * bflo(kv) + bfhi(kv) * bfhi(kv));
            kmax[h] = fmaxf(kmax[h], k2); if (lane == 0) NRM[h * S + t] = q2; } }
      if (lane == 0) {
#pragma unroll
        for (int h = 0; h < 4; ++h) { if (F.gw < 2048) NRM[4 * S + h * 2048 + F.gw] = kmax[h]; } } }
    if (blockIdx.x < 4) { const int h = blockIdx.x; LAS double* wt = (LAS double*)(F.lds + 131072 - 256);
        double loc[16]; double run = 0.0; const float bfh = bf_[h];
#pragma unroll
        for (int k = 0; k < 16; ++k) { const float x = bf2f(P[(size_t)(F.tid * 16 + k) * NP + COL_MISC + MI_BFL + h]) + bfh; run += (double)(fminf(x, 0.f) - log1pf(__expf(-fabsf(x)))); loc[k] = run; }
        double sc = run;
#pragma unroll
        for (int o = 1; o < 64; o <<= 1) { const double u = __shfl_up(sc, o); if (lane >= o) sc += u; }
        if (lane == 63) wt[F.wave] = sc;
        __syncthreads();
        double off = sc - run;
        for (int w = 0; w < F.wave; ++w) off += wt[w];
#pragma unroll
        for (int k = 0; k < 16; ++k) CUM[(size_t)h * S + F.tid * 16 + k] = (float)(off + loc[k]);
        __syncthreads();
    }
}
__device__ __forceinline__ void combine_phase(const Frame& F, const unsigned char* ws, bf16* BR) {
    const int lane = F.lane, h = lane >> 4;
    const bf16* OA = (const bf16*)(ws + WS_OA); const bf16* PB = (const bf16*)(ws + WS_PB); const bf16* PC = (const bf16*)(ws + WS_PC); const bf16* PS = (const bf16*)(ws + WS_PS);
    const bf16* OCMP = (const bf16*)(ws + WS_OCMP); const bf16* OWIN = (const bf16*)(ws + WS_OWIN);
    const float* LA = (const float*)(ws + WS_LSEA); const float* LB = (const float*)(ws + WS_LSEB); const float* LC = (const float*)(ws + WS_LSEC); const float* LS = (const float*)(ws + WS_LSES);
    const bf16* P = (const bf16*)(ws + WS_P);
    for (int t = F.gw; t < S; t += F.NGW) {
        const int qb = t >> 8, mB = qb >> 2, nchB = mB + 1, rowB = (2 * mB * (mB + 1) + (qb & 3) * (mB + 1)) * 256 + (t & 255);
        const int bs = t >> 6, mS = bs >> 4, nchS = mS + 1, rowS = (8 * mS * (mS + 1) + (bs & 15) * (mS + 1)) * 64 + (t & 63);
        const size_t eo = (size_t)t * 512 + 8 * lane;
        float r[8];
#define COMBINE(PBUF, LBUF, NCH, ROW0, RSTEP) do { float mx = -1e30f; float lv[8]; \
            _Pragma("unroll") for (int c = 0; c < 8; ++c) { lv[c] = c < (NCH) ? (LBUF)[((size_t)(ROW0) + (size_t)c * (RSTEP)) * 4 + h] : -1e30f; mx = fmaxf(mx, lv[c]); } \
            float ws_ = 0.f; _Pragma("unroll") for (int i = 0; i < 8; ++i) r[i] = 0.f; \
            _Pragma("unroll") for (int c = 0; c < 8; ++c) { if (c < (NCH) && lv[c] > -1e29f) { const float w = __expf(lv[c] - mx); const v4u v = *(const v4u*)((PBUF) + ((size_t)(ROW0) + (size_t)c * (RSTEP)) * 512 + 8 * lane); ws_ += w; \
                r[0] += w * bflo(v.x); r[1] += w * bfhi(v.x); r[2] += w * bflo(v.y); r[3] += w * bfhi(v.y); r[4] += w * bflo(v.z); r[5] += w * bfhi(v.z); r[6] += w * bflo(v.w); r[7] += w * bfhi(v.w); } } \
            const float inv = ws_ > 0.f ? 1.f / ws_ : 0.f; _Pragma("unroll") for (int i = 0; i < 8; ++i) r[i] *= inv; } while (0)
#define STORE8(dst) do { v4u o_; o_.x = pk2(r[0], r[1]); o_.y = pk2(r[2], r[3]); o_.z = pk2(r[4], r[5]); o_.w = pk2(r[6], r[7]); *(v4u*)(dst) = o_; } while (0)
        COMBINE(OA, LA, 3, t, S);
#if defined(ZERO_BR) && ZERO_BR == 0
        for (int i = 0; i < 8; ++i) r[i] = 0.f;
#endif
        STORE8(BR + eo);
        COMBINE(PB, LB, nchB, rowB, 256);
#if defined(ZERO_BR) && ZERO_BR == 1
        for (int i = 0; i < 8; ++i) r[i] = 0.f;
#endif
        STORE8(BR + (size_t)S * 512 + eo);
        COMBINE(PC, LC, nchB, rowB, 256);
#if defined(ZERO_BR) && ZERO_BR == 2
        for (int i = 0; i < 8; ++i) r[i] = 0.f;
#endif
        STORE8(BR + (size_t)2 * S * 512 + eo);
        COMBINE(PS, LS, nchS, rowS, 64);
        const bf16* dg = P + (size_t)t * NP + COL_MISC + MI_DG + 3 * h;
        float g0 = 1.f / (1.f + __expf(-bf2f(dg[0]))), g1 = 1.f / (1.f + __expf(-bf2f(dg[1]))), g2 = 1.f / (1.f + __expf(-bf2f(dg[2])));
#if defined(ZERO_BR) && ZERO_BR == 3
        g0 = 0.f; g1 = 0.f; g2 = 0.f;
#elif defined(ZERO_BR) && ZERO_BR == 4
        g0 = 0.f;
#elif defined(ZERO_BR) && ZERO_BR == 5
        g1 = 0.f;
#elif defined(ZERO_BR) && ZERO_BR == 6
        g2 = 0.f;
#endif
        const v4u vc = *(const v4u*)(OCMP + eo), vw = *(const v4u*)(OWIN + eo);
        r[0] = g0 * bflo(vc.x) + g1 * r[0] + g2 * bflo(vw.x); r[1] = g0 * bfhi(vc.x) + g1 * r[1] + g2 * bfhi(vw.x);
        r[2] = g0 * bflo(vc.y) + g1 * r[2] + g2 * bflo(vw.y); r[3] = g0 * bfhi(vc.y) + g1 * r[3] + g2 * bfhi(vw.y);
        r[4] = g0 * bflo(vc.z) + g1 * r[4] + g2 * bflo(vw.z); r[5] = g0 * bfhi(vc.z) + g1 * r[5] + g2 * bfhi(vw.z);
        r[6] = g0 * bflo(vc.w) + g1 * r[6] + g2 * bflo(vw.w); r[7] = g0 * bfhi(vc.w) + g1 * r[7] + g2 * bfhi(vw.w);
        STORE8(BR + (size_t)3 * S * 512 + eo);
#undef COMBINE
#undef STORE8
    }
}
__device__ __forceinline__ void cmp_select(const bf16* IMPH, unsigned* SEL, int q0, LAS char* lds, int tid) {
    LAS float* imp = (LAS float*)lds;
    asm volatile("" : "+v"(tid));
    const int lane = tid & 63;
    {
        const int q = tid & 63, cg = tid >> 6; const bf16* row = IMPH + (size_t)(q0 + q) * 512 + cg * 16;
        float acc[16];
#pragma unroll
        for (int e = 0; e < 16; ++e) acc[e] = 0.f;
#pragma unroll
        for (int h = 0; h < 4; ++h)
#pragma unroll
            for (int c = 0; c < 2; ++c) { const v4u v = *(const v4u*)(row + h * 128 + c * 8);
                acc[c * 8 + 0] += bflo(v.x); acc[c * 8 + 1] += bfhi(v.x); acc[c * 8 + 2] += bflo(v.y); acc[c * 8 + 3] += bfhi(v.y);
                acc[c * 8 + 4] += bflo(v.z); acc[c * 8 + 5] += bfhi(v.z); acc[c * 8 + 6] += bflo(v.w); acc[c * 8 + 7] += bfhi(v.w); }
#pragma unroll
        for (int e = 0; e < 16; ++e) imp[(cg * 16 + e) * 64 + q] = acc[e];
    }
    __syncthreads();
    if (tid < 64) {
        const int t = q0 + lane, cur = q0 >> 6;
        unsigned s0 = 0u, s1 = 0u, s2 = 0u, s3 = 0u;
#define SETBIT(j) do { const int j_ = (j); const unsigned b_ = 1u << (j_ & 31); if (j_ < 32) s0 |= b_; else if (j_ < 64) s1 |= b_; else if (j_ < 96) s2 |= b_; else s3 |= b_; } while (0)
        if (cur - 2 <= 13) { for (int j = 0; j <= cur; ++j) SETBIT(j); }
        else {
            SETBIT(0); SETBIT(cur); SETBIT(cur - 1);
            const int jmax = cur - 2;
#pragma unroll 1
            for (int it = 0; it < 13; ++it) { float best = -__builtin_inff(); int bi = 1;
#pragma unroll 1
                for (int j = 1; j <= jmax; ++j) { const float v = imp[j * 64 + lane]; const bool ok = v > best; best = ok ? v : best; bi = ok ? j : bi; }
                imp[bi * 64 + lane] = -__builtin_inff();
                SETBIT(bi); }
        }
#undef SETBIT
        const v4u o = {s0, s1, s2, s3}; *(v4u*)(SEL + (size_t)t * 4) = o;
    }
}
struct Args { const float* in[15]; float* out; unsigned char* ws; int ph_lo, ph_hi, grid, pad; };
typedef const __attribute__((address_space(4))) Args* CArgs;
constexpr int NPH = 14, PH_FINAL = 2 * NPH, PH_END = PH_FINAL + 1;

__device__ __forceinline__ void decode_bc(int u, int& head, int& qb, int& c, int& slot) {
    head = u & 3; const int v = u >> 2; int m;
    if (v < 112) { int rem = v; m = 7; while (rem >= 4 * m) { rem -= 4 * m; --m; } qb = 4 * m + rem / m; c = rem % m; }
    else { const int w = v - 112; m = w & 7; qb = 4 * m + 3 - (w >> 3); c = m; }
    slot = 2 * m * (m + 1) + (qb & 3) * (m + 1) + c;
}
__device__ __forceinline__ void decode_slc(int u, int& b, int& c, int& slot) {
    int m;
    if (u < 448) { int rem = u; m = 7; while (rem >= 16 * m) { rem -= 16 * m; --m; } b = 16 * m + rem / m; c = rem % m; }
    else { const int w = u - 448; m = w & 7; b = 16 * m + 15 - (w >> 3); c = m; }
    slot = 8 * m * (m + 1) + (b & 15) * (m + 1) + c;
}

__global__ void __launch_bounds__(NWAVES * 64, 2) hyb_fwd(Args args) {
    extern __shared__ __attribute__((aligned(16))) unsigned char lds_raw[];
#ifdef HYB_TIME
    if (blockIdx.x == 0 && threadIdx.x == 0) ((unsigned long long*)(args.ws + WS_CTL + 262144))[63] = __builtin_amdgcn_s_memrealtime();
#endif
    {
        LAS unsigned char* l0 = (LAS unsigned char*)lds_raw;
        for (int u = threadIdx.x; u < (LDS_BYTES - LDSCTL_OFF) / 4; u += NWAVES * 64) ((LAS unsigned*)(l0 + LDSCTL_OFF))[u] = 0u;
    }
    __syncthreads();
    (void)xcd_barrier_post((unsigned*)(args.ws + WS_CTL) + CW_BAR, (volatile LAS unsigned*)((LAS unsigned char*)lds_raw + MISC_OFF) + 8);
#define IN(k) (((CArgs)__builtin_amdgcn_kernarg_segment_ptr())->ph_lo <= (k) && (k) < ((CArgs)__builtin_amdgcn_kernarg_segment_ptr())->ph_hi)
#ifndef PHMASK
#define PHMASK 0x7fff
#endif
#define PHEN(k) (((PHMASK) >> (k)) & 1)
#define SEAM(k) do { if (IN(k) && IN((k) + 1)) { CArgs kb_ = (CArgs)__builtin_amdgcn_kernarg_segment_ptr(); asm volatile("" : "+s"(kb_)); \
        XcdBarrier b_; b_.bar = (unsigned*)(kb_->ws + WS_CTL) + CW_BAR; b_.x = xb_xcc_id(); b_.st = (volatile LAS unsigned*)((LAS unsigned char*)lds_raw + MISC_OFF) + 8; xcd_barrier(b_); } } while (0)
#define SEAM_FORCE() do { CArgs kb_ = (CArgs)__builtin_amdgcn_kernarg_segment_ptr(); XcdBarrier b_; b_.bar = (unsigned*)(kb_->ws + WS_CTL) + CW_BAR; b_.x = xb_xcc_id(); b_.st = (volatile LAS unsigned*)((LAS unsigned char*)lds_raw + MISC_OFF) + 8; xcd_barrier(b_); } while (0)
#ifndef TIME_BDIV
#define TIME_BDIV 10.f
#endif
#ifdef HYB_TIME
#define STAMP(k) do { if (blockIdx.x == 0 && threadIdx.x == 0) { CArgs ka_ = (CArgs)__builtin_amdgcn_kernarg_segment_ptr(); asm volatile("" : "+s"(ka_)); ((unsigned long long*)(ka_->ws + WS_CTL + 262144))[(k)] = __builtin_amdgcn_s_memrealtime(); } } while (0)
#else
#define STAMP(k) do { } while (0)
#endif

#define PHASE_BEGIN CArgs ka = (CArgs)__builtin_amdgcn_kernarg_segment_ptr(); asm volatile("" : "+s"(ka)); unsigned char* ws = ka->ws; Frame F; mkframe(F, lds_raw, ka->grid); LAS char* lds = (LAS char*)F.lds; (void)lds; (void)ws;
#define TAB ((float2*)(ws + WS_TAB))
#define TABI ((float2*)(ws + WS_TABI))
#define OVM ((bf16*)(ws + WS_OVM))
#define KI ((bf16*)(ws + WS_KI))
#define CUM ((float*)(ws + WS_CUM))
#define KVC ((bf16*)(ws + WS_KVC))
#define HID ((bf16*)(ws + WS_HID))
#define SEL ((unsigned*)(ws + WS_SEL))
#define CA ((bf16*)(ws + WS_CA))
#define BM ((unsigned*)(ws + WS_BM))
#define W2T ((bf16*)(ws + WS_W2T))
#define W1T ((bf16*)(ws + WS_W1T))
#define WB ((bf16*)(ws + WS_WB))
#define WO ((bf16*)(ws + WS_WO))
#define WIN_ ((bf16*)(ws + WS_WIN))
#define WG ((bf16*)(ws + WS_WG))
#define WFI ((bf16*)(ws + WS_WFI))
#define WFO ((bf16*)(ws + WS_WFO))
#define XN ((bf16*)(ws + WS_XN))
#define BR ((bf16*)(ws + WS_BR))
#define X2 ((float*)(ws + WS_X2))
#define P ((bf16*)(ws + WS_P))
#define MG ((bf16*)(ws + WS_MG))
#define SC ((float*)(ws + WS_SC))
#define Y ((bf16*)(ws + WS_Y))
#define ACT ((bf16*)(ws + WS_ACT))
#define X1 (ka->out)
#define XIN (L == 0 ? ka->in[0] : (const float*)X2)

    { constexpr int L = 0;

        const int pb = L * NPH;
        STAMP(pb + 0);
        if (PHEN(0) && IN(pb + 0)) { PHASE_BEGIN
            if (L == 0) transpose_all<MAP_IN>(F, ka->in[2] + (size_t)L * DM * 10080, DM, 10080, NP, WIN_);
            for (int kv = 0; kv < 2; ++kv) { transpose_all<MAP_ID>(F, ka->in[7] + ((size_t)L * 2 + kv) * 4096 * 256, 4096, 256, 256, W1T + (size_t)kv * 256 * 4096);
                                             if (kv == 0) transpose_all<MAP_W2P>(F, ka->in[8] + ((size_t)L * 2 + kv) * 256 * 128, 256, 128, 256, W2T + (size_t)kv * 256 * 256);
                                             else transpose_all<MAP_W2>(F, ka->in[8] + ((size_t)L * 2 + kv) * 256 * 128, 256, 128, 256, W2T + (size_t)kv * 256 * 256); }
            if (L == 0) build_tables(F, TAB, TABI, OVM);
            for (int m = F.gw; m < S; m += F.NGW) rms_row(XIN + (size_t)m * DM, ka->in[1] + (size_t)L * DM, XN + (size_t)m * DM, nullptr, F.lane);
        }
        SEAM(pb + 0);
        STAMP(pb + 1);
        if (PHEN(1) && IN(pb + 1)) { PHASE_BEGIN
            pg8::Gemm g{XN, WIN_, S, NP, DM, DM}; pg8::StaticOrder So; So.init(S, NP, F.G, (int)blockIdx.x);
            pg8::EpiProj E{P, (const float*)TAB, (const float*)TABI};
            pg8::gemm_phase<pg8::EpiProj, pg8::StaticOrder, true, true>(F.lds, g, So, E);
        }
        SEAM(pb + 1);
        STAMP(pb + 2);
        if (PHEN(2) && IN(pb + 2)) { PHASE_BEGIN prep_phase(F, P, CA, CUM, (float*)(ws + WS_NRM), ka->in[6] + (size_t)L * 2 * 32 * 128, ka->in[5] + (size_t)L * 4); }
        SEAM(pb + 2);
        STAMP(pb + 3);
        if (PHEN(3) && IN(pb + 3)) { PHASE_BEGIN
            { pg8::Gemm g{CA, W1T, 1024, 512, 4096, 1024}; pg8::SplitKOrder So; So.init(F.G, (int)blockIdx.x);
              pg8::EpiPartial E{(float*)(ws + WS_HIDP)};
              pg8::gemm_phase<pg8::EpiPartial, pg8::SplitKOrder, true, true>(F.lds, g, So, E); }
            if (L == 0) STAMP(42);
#ifdef HYB_TIME
            if (L == 0 && blockIdx.x == 0 && threadIdx.x == 0) ((unsigned long long*)(ws + WS_CTL + 262144))[57] = 1ull;
#endif
            unsigned* qctr = (unsigned*)(ws + WS_CTL) + CW_QUEUE + 64 * (L * 4 + 0);
            for (;;) { const int u = next_unit(qctr, lds); if (u >= 576 + 1056) break;
                if (u < 576) { int head, qb, c, slot; decode_bc(u, head, qb, c, slot);
                    att::AttnP ap; ap.q_pitch = NP; ap.kv_pitch = NP; ap.o_pitch = 512; ap.lse_pitch = 4; ap.q_tstride = 1; ap.k_tok0 = 0; ap.k_tstride = 1; ap.bm = nullptr;
                    ap.Q = P + COL_BQ + head * 128; ap.K = P + COL_BK + head * 128; ap.V = P + COL_BV + head * 128; ap.cum = CUM + (size_t)head * S;
                    ap.O = (bf16*)(ws + WS_PB) + ((ptrdiff_t)slot * 256 - 256 * qb) * 512 + head * 128; ap.LSE = (float*)(ws + WS_LSEB) + ((ptrdiff_t)slot * 256 - 256 * qb) * 4 + head;
                    ap.q_tok0 = 256 * qb; ap.q_sub0 = 256 * qb; ap.j_lo = 16 * c; ap.j_hi = min(16 * c + 16, 4 * (qb + 1));
                    const float* nrm = (const float*)(ws + WS_NRM);
                    const int jsk = att::b_skip(ap.cum, 256 * qb, 4 * (qb + 1), nrm + (size_t)head * S + 256 * qb, nrm + 4 * S + head * 2048, min(F.NGW, 2048), lds);
#ifdef HYB_TIME
                    const unsigned long long tb0_ = __builtin_amdgcn_s_memrealtime();
#endif
                    if (jsk >= ap.j_hi) { att::write_empty_lse(ap.LSE, 256 * qb, 4); }
                    else { ap.j_lo = max(ap.j_lo, jsk); att::attn_unit<att::M_B, false>(ap, lds);
#ifdef B_TWICE
                        att::attn_unit<att::M_B, false>(ap, lds);
#endif
 }
#ifdef HYB_TIME
                    if (L == 0 && blockIdx.x == 0 && threadIdx.x == 0) { unsigned long long* ts_ = (unsigned long long*)(ws + WS_CTL + 262144); ts_[58] += __builtin_amdgcn_s_memrealtime() - tb0_; ts_[59] += 1ull; }
#endif
                } else { const int v = u - 576; const int pr = v / 66, w = v % 66; int qb, kc2; if (w < 2 * (pr + 1)) { qb = pr; kc2 = w; } else { qb = 31 - pr; kc2 = w - 2 * (pr + 1); }
#ifdef HYB_TIME
                    { const unsigned long long tq0_ = __builtin_amdgcn_s_memrealtime();
                    att::idx_unit(P, SC, qb, kc2, lds, (L == 0 && blockIdx.x == 0) ? (unsigned long long*)(ws + WS_CTL + 262144) + 53 : nullptr);
                    if (L == 0 && blockIdx.x == 0 && threadIdx.x == 0) ((unsigned long long*)(ws + WS_CTL + 262144))[56] += __builtin_amdgcn_s_memrealtime() - tq0_; }
#else
                    att::idx_unit(P, SC, qb, kc2, lds);
#endif
#ifdef IDX_TWICE
                    att::idx_unit(P, SC, qb, kc2, lds);
#endif
 }
            }
        #ifdef HYB_TIME
            if (L == 0 && threadIdx.x == 0) { unsigned long long* ts_ = (unsigned long long*)(ws + WS_CTL + 262144); const unsigned long long now_ = __builtin_amdgcn_s_memrealtime(); atomicMax(ts_ + 44, now_); atomicMax(ts_ + 45, (1ull << 40) - now_); }
#endif
        }
        SEAM(pb + 3);
        STAMP(pb + 4);
        if (PHEN(4) && IN(pb + 4)) { PHASE_BEGIN
            if (blockIdx.x < 4) {
                const float* hp = (const float*)(ws + WS_HIDP) + (size_t)blockIdx.x * 256 * 256;
                for (int i = F.tid; i < 256 * 256 / 4; i += 512) { f32x4 s4 = *(const f32x4*)(hp + 4 * i);
#pragma unroll
                    for (int q = 1; q < 4; ++q) s4 = s4 + *(const f32x4*)(hp + (size_t)q * 1024 * 256 + 4 * i);
                    float o4[4];
#pragma unroll
                    for (int e = 0; e < 4; ++e) { const float x = s4[e]; const float tt = 0.7978845608028654f * (x + 0.044715f * x * x * x); const float ee = __expf(2.f * tt); o4[e] = 0.5f * x * (2.f - 2.f / (ee + 1.f)); }
                    v2u o; o.x = pk2(o4[0], o4[1]); o.y = pk2(o4[2], o4[3]); *(v2u*)(HID + (size_t)blockIdx.x * 256 * 256 + 4 * i) = o; }
                VM_WAIT(); __syncthreads();
            }
            { pg8::Gemm g{HID, W2T, 1024, 512, 256, 256}; pg8::StackOrder So; So.init(2, 1, 2, F.G, (int)blockIdx.x);
              pg8::EpiPlain<0> E{KVC, 128, 1, 128};
              pg8::gemm_phase<pg8::EpiPlain<0>, pg8::StackOrder, true, true>(F.lds, g, So, E); }
            unsigned* qctr = (unsigned*)(ws + WS_CTL) + CW_QUEUE + 64 * (L * 4 + 1);
            for (;;) { const int uq = next_unit(qctr, lds); if (uq >= 1024) break;
                if (uq < 256 || uq >= 768) { const bool heavy = uq < 256; const int su = heavy ? uq : uq - 768;
                    int tl = threadIdx.x; asm volatile("" : "+v"(tl)); const int w8 = su * 8 + __builtin_amdgcn_readfirstlane(tl >> 6), ln = tl & 63;
                    if (heavy) {
#ifdef SEL_TWICE
#pragma unroll 1
                        for (int jj = 0; jj < 4; ++jj) att::select_row<128>(SC, BM, (jj & 1) ? 8191 - w8 : 4096 + w8, ln);
#else
#pragma unroll 1
                        for (int jj = 0; jj < 2; ++jj) att::select_row<128>(SC, BM, jj ? 8191 - w8 : 4096 + w8, ln);
#endif
                    } else { att::select_row<32>(SC, BM, w8, ln); att::select_row<64>(SC, BM, 4095 - w8, ln); }
                    continue; }
                const int u = uq - 256;
                att::AttnP ap; ap.q_pitch = NP; ap.kv_pitch = NP; ap.o_pitch = 512; ap.lse_pitch = 4; ap.bm = nullptr; ap.cum = nullptr;
                if (u < 128) { const int b = 127 - u; const int q0 = 64 * b;
                    ap.q_tstride = 1; ap.k_tok0 = 0; ap.k_tstride = 1;
                    ap.Q = P + COL_DQ; ap.K = P + COL_DKW; ap.V = P + COL_DVW; ap.O = (bf16*)(ws + WS_OWIN); ap.LSE = nullptr;
                    ap.q_tok0 = q0; ap.q_sub0 = q0; ap.j_lo = q0 >= 511 ? (q0 - 511) >> 6 : 0; ap.j_hi = b + 1;
                    att::attn_unit<att::M_WIN, true>(ap, lds);
                } else { const int v = u - 128; const int hh = v & 3, g = (v >> 2) % 3, blk = v / 12;
                    const int r = g == 0 ? 1 : (g == 1 ? 4 : 16); const int nper = 32 / r;
                    const int res = blk / nper, n = blk % nper; const int head = g * 4 + hh;
                    ap.Q = P + COL_AQ + head * 128; ap.K = P + COL_AK + head * 128; ap.V = P + COL_AV + head * 128;
                    ap.O = (bf16*)(ws + WS_OA) + (size_t)g * S * 512 + hh * 128; ap.LSE = (float*)(ws + WS_LSEA) + (size_t)g * S * 4 + hh;
                    ap.q_tok0 = res + r * 256 * n; ap.q_tstride = r; ap.q_sub0 = 256 * n; ap.k_tok0 = res; ap.k_tstride = r;
                    ap.j_lo = n == 0 ? 0 : 4 * n - 2; ap.j_hi = 4 * n + 4;
                    att::attn_unit<att::M_A, false>(ap, lds); }
            }
        }
        SEAM(pb + 4);
        STAMP(pb + 5);
        if (PHEN(5) && IN(pb + 5)) { PHASE_BEGIN
            transpose_all<MAP_GATE>(F, ka->in[3] + (size_t)L * DM * 8192, DM, 8192, 8192, WG);
            for (int b = 0; b < 4; ++b) transpose_all<MAP_ID>(F, ka->in[9] + ((size_t)L * 4 + b) * 512 * DM, 512, DM, DM, WB + (size_t)b * DM * 512);
            transpose_all<MAP_ID>(F, ka->in[10] + (size_t)L * DM * DM, DM, DM, DM, WO);
            unsigned* qctr = (unsigned*)(ws + WS_CTL) + CW_QUEUE + 64 * (L * 4 + 2);
            for (;;) { const int u = next_unit(qctr, lds); if (u >= 576 + 128) break;
                att::AttnP ap; ap.q_pitch = NP; ap.o_pitch = 512; ap.lse_pitch = 4; ap.q_tstride = 1; ap.k_tok0 = 0; ap.k_tstride = 1; ap.cum = nullptr;
                if (u >= 128) { int head, qb, c, slot; decode_bc(u - 128, head, qb, c, slot);
                    ap.Q = P + COL_CQ + head * 128; ap.K = P + COL_CK + head * 128; ap.V = P + COL_CV + head * 128; ap.kv_pitch = NP; ap.bm = BM;
                    ap.O = (bf16*)(ws + WS_PC) + ((ptrdiff_t)slot * 256 - 256 * qb) * 512 + head * 128; ap.LSE = (float*)(ws + WS_LSEC) + ((ptrdiff_t)slot * 256 - 256 * qb) * 4 + head;
                    ap.q_tok0 = 256 * qb; ap.q_sub0 = 256 * qb; ap.j_lo = 16 * c; ap.j_hi = min(16 * c + 16, 4 * (qb + 1));
                    att::attn_unit<att::M_C, false>(ap, lds);
                } else { const int b = 127 - u; const int q0 = 64 * b;
                    ap.Q = P + COL_DQ; ap.K = KVC; ap.V = KVC + 512 * 128; ap.kv_pitch = 128; ap.bm = nullptr; ap.LSE = nullptr;
                    ap.q_tok0 = q0; ap.q_sub0 = q0; ap.j_lo = 0; ap.j_hi = 8;
                    ap.O = (bf16*)(ws + WS_OCMP); att::attn_unit<att::M_CMP, true>(ap, lds);
                    ap.V = OVM; ap.O = (bf16*)(ws + WS_IMPH); att::attn_unit<att::M_CMP, true>(ap, lds);
                    __syncthreads();
                    cmp_select((const bf16*)(ws + WS_IMPH), SEL, q0, lds, F.tid); }
            }
        }
        SEAM(pb + 5);
        STAMP(pb + 6);
        if (PHEN(6) && IN(pb + 6)) { PHASE_BEGIN
            unsigned* qctr = (unsigned*)(ws + WS_CTL) + CW_QUEUE + 64 * (L * 4 + 3);
            for (;;) { const int u = next_unit(qctr, lds); if (u >= 576) break; int b, c, slot; decode_slc(u, b, c, slot);
                att::AttnP ap; ap.q_pitch = NP; ap.kv_pitch = NP; ap.o_pitch = 512; ap.lse_pitch = 4; ap.q_tstride = 1; ap.k_tok0 = 0; ap.k_tstride = 1; ap.cum = nullptr; ap.bm = SEL;
                ap.Q = P + COL_DQ; ap.K = P + COL_DKS; ap.V = P + COL_DVS; ap.O = (bf16*)(ws + WS_PS) + ((ptrdiff_t)slot * 64 - 64 * b) * 512; ap.LSE = (float*)(ws + WS_LSES) + ((ptrdiff_t)slot * 64 - 64 * b) * 4;
                ap.q_tok0 = 64 * b; ap.q_sub0 = 64 * b; ap.j_lo = 16 * c; ap.j_hi = min(16 * c + 16, b + 1);
#ifdef HYB_TIME
                const unsigned long long t0_ = __builtin_amdgcn_s_memrealtime();
#endif
                att::attn_unit<att::M_SLC, true>(ap, lds);
#ifdef HYB_TIME
                if (L == 0 && blockIdx.x == 0 && threadIdx.x == 0) { unsigned long long* ts_ = (unsigned long long*)(ws + WS_CTL + 262144); ts_[50] += __builtin_amdgcn_s_memrealtime() - t0_; ts_[51] += (unsigned long long)(ap.j_hi - ap.j_lo); ts_[52] += 1ull; }
#endif
 }
        }
        SEAM(pb + 6);
        STAMP(pb + 7);
        if (PHEN(7) && IN(pb + 7)) { PHASE_BEGIN combine_phase(F, ws, BR); }
        SEAM(pb + 7);
        STAMP(pb + 8);
        if (PHEN(8) && IN(pb + 8)) { PHASE_BEGIN
            pg8::Gemm g{BR, WB, 4 * S, 4 * DM, 512, 512}; pg8::StackOrder So; So.init(32, 8, 4, F.G, (int)blockIdx.x);
            pg8::EpiPlain<0> E{Y, DM, 8, DM};
            pg8::gemm_phase<pg8::EpiPlain<0>, pg8::StackOrder, true, true>(F.lds, g, So, E);
        }
        SEAM(pb + 8);
        STAMP(pb + 9);
        if (PHEN(9) && IN(pb + 9)) { PHASE_BEGIN
            pg8::Gemm g{XN, WG, S, 8192, DM, DM}; pg8::StaticOrder So; So.init(S, 8192, F.G, (int)blockIdx.x);
            pg8::EpiGate E{Y, ka->in[4] + (size_t)L * 4 * DM, MG};
            pg8::gemm_phase<pg8::EpiGate, pg8::StaticOrder, true, true>(F.lds, g, So, E);
        }
        SEAM(pb + 9);
        STAMP(pb + 10);
        if (PHEN(10) && IN(pb + 10)) { PHASE_BEGIN
            pg8::Gemm g{MG, WO, S, DM, DM, DM}; pg8::StaticOrder So; So.init(S, DM, F.G, (int)blockIdx.x);
            pg8::EpiRes E{XIN, X1};
            pg8::gemm_phase<pg8::EpiRes, pg8::StaticOrder, true, true>(F.lds, g, So, E);
        }
        SEAM(pb + 10);
        STAMP(pb + 11);
        if (PHEN(11) && IN(pb + 11)) { PHASE_BEGIN
            transpose_all<MAP_FFI>(F, ka->in[12] + (size_t)L * DM * NFF2, DM, NFF2, NFF2, WFI);
            for (int m = F.gw; m < S; m += F.NGW) rms_row(X1 + (size_t)m * DM, ka->in[11] + (size_t)L * DM, XN + (size_t)m * DM, nullptr, F.lane); }
        SEAM(pb + 11);
        STAMP(pb + 12);
        if (PHEN(12) && IN(pb + 12)) { PHASE_BEGIN
            pg8::Gemm g{XN, WFI, S, NFF2, DM, DM}; pg8::StaticOrder So; So.init(S, NFF2, F.G, (int)blockIdx.x);
            pg8::EpiSwiglu E{ACT};
            pg8::gemm_phase<pg8::EpiSwiglu, pg8::StaticOrder, true, true>(F.lds, g, So, E);
            if (F.G != 256 || blockIdx.x >= 128) {
                __syncthreads();
                const int gw2 = F.G != 256 ? F.gw : ((int)blockIdx.x - 128) * NWAVES + F.wave, ngw2 = F.G != 256 ? F.NGW : 128 * NWAVES;
                transpose_some<MAP_ID>(F, gw2, ngw2, ka->in[13] + (size_t)L * NFF * DM, NFF, DM, DM, WFO);
                if (L == 0) transpose_some<MAP_IN>(F, gw2, ngw2, ka->in[2] + (size_t)1 * DM * 10080, DM, 10080, NP, WIN_);
            }
        }
        SEAM(pb + 12);
        STAMP(pb + 13);
        if (PHEN(13) && IN(pb + 13)) { PHASE_BEGIN
            pg8::Gemm g{ACT, WFO, S, DM, NFF, NFF}; pg8::StaticOrder So; So.init(S, DM, F.G, (int)blockIdx.x);
            pg8::EpiRes E{X1, X2};
            pg8::gemm_phase<pg8::EpiRes, pg8::StaticOrder, true, true>(F.lds, g, So, E);
        }
        SEAM(pb + 13);

    }
    { constexpr int L = 1;

        const int pb = L * NPH;
        STAMP(pb + 0);
        if (PHEN(0) && IN(pb + 0)) { PHASE_BEGIN
            if (L == 0) transpose_all<MAP_IN>(F, ka->in[2] + (size_t)L * DM * 10080, DM, 10080, NP, WIN_);
            for (int kv = 0; kv < 2; ++kv) { transpose_all<MAP_ID>(F, ka->in[7] + ((size_t)L * 2 + kv) * 4096 * 256, 4096, 256, 256, W1T + (size_t)kv * 256 * 4096);
                                             if (kv == 0) transpose_all<MAP_W2P>(F, ka->in[8] + ((size_t)L * 2 + kv) * 256 * 128, 256, 128, 256, W2T + (size_t)kv * 256 * 256);
                                             else transpose_all<MAP_W2>(F, ka->in[8] + ((size_t)L * 2 + kv) * 256 * 128, 256, 128, 256, W2T + (size_t)kv * 256 * 256); }
            if (L == 0) build_tables(F, TAB, TABI, OVM);
            for (int m = F.gw; m < S; m += F.NGW) rms_row(XIN + (size_t)m * DM, ka->in[1] + (size_t)L * DM, XN + (size_t)m * DM, nullptr, F.lane);
        }
        SEAM(pb + 0);
        STAMP(pb + 1);
        if (PHEN(1) && IN(pb + 1)) { PHASE_BEGIN
            pg8::Gemm g{XN, WIN_, S, NP, DM, DM}; pg8::StaticOrder So; So.init(S, NP, F.G, (int)blockIdx.x);
            pg8::EpiProj E{P, (const float*)TAB, (const float*)TABI};
            pg8::gemm_phase<pg8::EpiProj, pg8::StaticOrder, true, true>(F.lds, g, So, E);
        }
        SEAM(pb + 1);
        STAMP(pb + 2);
        if (PHEN(2) && IN(pb + 2)) { PHASE_BEGIN prep_phase(F, P, CA, CUM, (float*)(ws + WS_NRM), ka->in[6] + (size_t)L * 2 * 32 * 128, ka->in[5] + (size_t)L * 4); }
        SEAM(pb + 2);
        STAMP(pb + 3);
        if (PHEN(3) && IN(pb + 3)) { PHASE_BEGIN
            { pg8::Gemm g{CA, W1T, 1024, 512, 4096, 1024}; pg8::SplitKOrder So; So.init(F.G, (int)blockIdx.x);
              pg8::EpiPartial E{(float*)(ws + WS_HIDP)};
              pg8::gemm_phase<pg8::EpiPartial, pg8::SplitKOrder, true, true>(F.lds, g, So, E); }
            if (L == 0) STAMP(42);
#ifdef HYB_TIME
            if (L == 0 && blockIdx.x == 0 && threadIdx.x == 0) ((unsigned long long*)(ws + WS_CTL + 262144))[57] = 1ull;
#endif
            unsigned* qctr = (unsigned*)(ws + WS_CTL) + CW_QUEUE + 64 * (L * 4 + 0);
            for (;;) { const int u = next_unit(qctr, lds); if (u >= 576 + 1056) break;
                if (u < 576) { int head, qb, c, slot; decode_bc(u, head, qb, c, slot);
                    att::AttnP ap; ap.q_pitch = NP; ap.kv_pitch = NP; ap.o_pitch = 512; ap.lse_pitch = 4; ap.q_tstride = 1; ap.k_tok0 = 0; ap.k_tstride = 1; ap.bm = nullptr;
                    ap.Q = P + COL_BQ + head * 128; ap.K = P + COL_BK + head * 128; ap.V = P + COL_BV + head * 128; ap.cum = CUM + (size_t)head * S;
                    ap.O = (bf16*)(ws + WS_PB) + ((ptrdiff_t)slot * 256 - 256 * qb) * 512 + head * 128; ap.LSE = (float*)(ws + WS_LSEB) + ((ptrdiff_t)slot * 256 - 256 * qb) * 4 + head;
                    ap.q_tok0 = 256 * qb; ap.q_sub0 = 256 * qb; ap.j_lo = 16 * c; ap.j_hi = min(16 * c + 16, 4 * (qb + 1));
                    const float* nrm = (const float*)(ws + WS_NRM);
                    const int jsk = att::b_skip(ap.cum, 256 * qb, 4 * (qb + 1), nrm + (size_t)head * S + 256 * qb, nrm + 4 * S + head * 2048, min(F.NGW, 2048), lds);
#ifdef HYB_TIME
                    const unsigned long long tb0_ = __builtin_amdgcn_s_memrealtime();
#endif
                    if (jsk >= ap.j_hi) { att::write_empty_lse(ap.LSE, 256 * qb, 4); }
                    else { ap.j_lo = max(ap.j_lo, jsk); att::attn_unit<att::M_B, false>(ap, lds);
#ifdef B_TWICE
                        att::attn_unit<att::M_B, false>(ap, lds);
#endif
 }
#ifdef HYB_TIME
                    if (L == 0 && blockIdx.x == 0 && threadIdx.x == 0) { unsigned long long* ts_ = (unsigned long long*)(ws + WS_CTL + 262144); ts_[58] += __builtin_amdgcn_s_memrealtime() - tb0_; ts_[59] += 1ull; }
#endif
                } else { const int v = u - 576; const int pr = v / 66, w = v % 66; int qb, kc2; if (w < 2 * (pr + 1)) { qb = pr; kc2 = w; } else { qb = 31 - pr; kc2 = w - 2 * (pr + 1); }
#ifdef HYB_TIME
                    { const unsigned long long tq0_ = __builtin_amdgcn_s_memrealtime();
                    att::idx_unit(P, SC, qb, kc2, lds, (L == 0 && blockIdx.x == 0) ? (unsigned long long*)(ws + WS_CTL + 262144) + 53 : nullptr);
                    if (L == 0 && blockIdx.x == 0 && threadIdx.x == 0) ((unsigned long long*)(ws + WS_CTL + 262144))[56] += __builtin_amdgcn_s_memrealtime() - tq0_; }
#else
                    att::idx_unit(P, SC, qb, kc2, lds);
#endif
#ifdef IDX_TWICE
                    att::idx_unit(P, SC, qb, kc2, lds);
#endif
 }
            }
        #ifdef HYB_TIME
            if (L == 0 && threadIdx.x == 0) { unsigned long long* ts_ = (unsigned long long*)(ws + WS_CTL + 262144); const unsigned long long now_ = __builtin_amdgcn_s_memrealtime(); atomicMax(ts_ + 44, now_); atomicMax(ts_ + 45, (1ull << 40) - now_); }
#endif
        }
        SEAM(pb + 3);
        STAMP(pb + 4);
        if (PHEN(4) && IN(pb + 4)) { PHASE_BEGIN
            if (blockIdx.x < 4) {
                const float* hp = (const float*)(ws + WS_HIDP) + (size_t)blockIdx.x * 256 * 256;
                for (int i = F.tid; i < 256 * 256 / 4; i += 512) { f32x4 s4 = *(const f32x4*)(hp + 4 * i);
#pragma unroll
                    for (int q = 1; q < 4; ++q) s4 = s4 + *(const f32x4*)(hp + (size_t)q * 1024 * 256 + 4 * i);
                    float o4[4];
#pragma unroll
                    for (int e = 0; e < 4; ++e) { const float x = s4[e]; const float tt = 0.7978845608028654f * (x + 0.044715f * x * x * x); const float ee = __expf(2.f * tt); o4[e] = 0.5f * x * (2.f - 2.f / (ee + 1.f)); }
                    v2u o; o.x = pk2(o4[0], o4[1]); o.y = pk2(o4[2], o4[3]); *(v2u*)(HID + (size_t)blockIdx.x * 256 * 256 + 4 * i) = o; }
                VM_WAIT(); __syncthreads();
            }
            { pg8::Gemm g{HID, W2T, 1024, 512, 256, 256}; pg8::StackOrder So; So.init(2, 1, 2, F.G, (int)blockIdx.x);
              pg8::EpiPlain<0> E{KVC, 128, 1, 128};
              pg8::gemm_phase<pg8::EpiPlain<0>, pg8::StackOrder, true, true>(F.lds, g, So, E); }
            unsigned* qctr = (unsigned*)(ws + WS_CTL) + CW_QUEUE + 64 * (L * 4 + 1);
            for (;;) { const int uq = next_unit(qctr, lds); if (uq >= 1024) break;
                if (uq < 256 || uq >= 768) { const bool heavy = uq < 256; const int su = heavy ? uq : uq - 768;
                    int tl = threadIdx.x; asm volatile("" : "+v"(tl)); const int w8 = su * 8 + __builtin_amdgcn_readfirstlane(tl >> 6), ln = tl & 63;
                    if (heavy) {
#ifdef SEL_TWICE
#pragma unroll 1
                        for (int jj = 0; jj < 4; ++jj) att::select_row<128>(SC, BM, (jj & 1) ? 8191 - w8 : 4096 + w8, ln);
#else
#pragma unroll 1
                        for (int jj = 0; jj < 2; ++jj) att::select_row<128>(SC, BM, jj ? 8191 - w8 : 4096 + w8, ln);
#endif
                    } else { att::select_row<32>(SC, BM, w8, ln); att::select_row<64>(SC, BM, 4095 - w8, ln); }
                    continue; }
                const int u = uq - 256;
                att::AttnP ap; ap.q_pitch = NP; ap.kv_pitch = NP; ap.o_pitch = 512; ap.lse_pitch = 4; ap.bm = nullptr; ap.cum = nullptr;
                if (u < 128) { const int b = 127 - u; const int q0 = 64 * b;
                    ap.q_tstride = 1; ap.k_tok0 = 0; ap.k_tstride = 1;
                    ap.Q = P + COL_DQ; ap.K = P + COL_DKW; ap.V = P + COL_DVW; ap.O = (bf16*)(ws + WS_OWIN); ap.LSE = nullptr;
                    ap.q_tok0 = q0; ap.q_sub0 = q0; ap.j_lo = q0 >= 511 ? (q0 - 511) >> 6 : 0; ap.j_hi = b + 1;
                    att::attn_unit<att::M_WIN, true>(ap, lds);
                } else { const int v = u - 128; const int hh = v & 3, g = (v >> 2) % 3, blk = v / 12;
                    const int r = g == 0 ? 1 : (g == 1 ? 4 : 16); const int nper = 32 / r;
                    const int res = blk / nper, n = blk % nper; const int head = g * 4 + hh;
                    ap.Q = P + COL_AQ + head * 128; ap.K = P + COL_AK + head * 128; ap.V = P + COL_AV + head * 128;
                    ap.O = (bf16*)(ws + WS_OA) + (size_t)g * S * 512 + hh * 128; ap.LSE = (float*)(ws + WS_LSEA) + (size_t)g * S * 4 + hh;
                    ap.q_tok0 = res + r * 256 * n; ap.q_tstride = r; ap.q_sub0 = 256 * n; ap.k_tok0 = res; ap.k_tstride = r;
                    ap.j_lo = n == 0 ? 0 : 4 * n - 2; ap.j_hi = 4 * n + 4;
                    att::attn_unit<att::M_A, false>(ap, lds); }
            }
        }
        SEAM(pb + 4);
        STAMP(pb + 5);
        if (PHEN(5) && IN(pb + 5)) { PHASE_BEGIN
            transpose_all<MAP_GATE>(F, ka->in[3] + (size_t)L * DM * 8192, DM, 8192, 8192, WG);
            for (int b = 0; b < 4; ++b) transpose_all<MAP_ID>(F, ka->in[9] + ((size_t)L * 4 + b) * 512 * DM, 512, DM, DM, WB + (size_t)b * DM * 512);
            transpose_all<MAP_ID>(F, ka->in[10] + (size_t)L * DM * DM, DM, DM, DM, WO);
            unsigned* qctr = (unsigned*)(ws + WS_CTL) + CW_QUEUE + 64 * (L * 4 + 2);
            for (;;) { const int u = next_unit(qctr, lds); if (u >= 576 + 128) break;
                att::AttnP ap; ap.q_pitch = NP; ap.o_pitch = 512; ap.lse_pitch = 4; ap.q_tstride = 1; ap.k_tok0 = 0; ap.k_tstride = 1; ap.cum = nullptr;
                if (u >= 128) { int head, qb, c, slot; decode_bc(u - 128, head, qb, c, slot);
                    ap.Q = P + COL_CQ + head * 128; ap.K = P + COL_CK + head * 128; ap.V = P + COL_CV + head * 128; ap.kv_pitch = NP; ap.bm = BM;
                    ap.O = (bf16*)(ws + WS_PC) + ((ptrdiff_t)slot * 256 - 256 * qb) * 512 + head * 128; ap.LSE = (float*)(ws + WS_LSEC) + ((ptrdiff_t)slot * 256 - 256 * qb) * 4 + head;
                    ap.q_tok0 = 256 * qb; ap.q_sub0 = 256 * qb; ap.j_lo = 16 * c; ap.j_hi = min(16 * c + 16, 4 * (qb + 1));
                    att::attn_unit<att::M_C, false>(ap, lds);
                } else { const int b = 127 - u; const int q0 = 64 * b;
                    ap.Q = P + COL_DQ; ap.K = KVC; ap.V = KVC + 512 * 128; ap.kv_pitch = 128; ap.bm = nullptr; ap.LSE = nullptr;
                    ap.q_tok0 = q0; ap.q_sub0 = q0; ap.j_lo = 0; ap.j_hi = 8;
                    ap.O = (bf16*)(ws + WS_OCMP); att::attn_unit<att::M_CMP, true>(ap, lds);
                    ap.V = OVM; ap.O = (bf16*)(ws + WS_IMPH); att::attn_unit<att::M_CMP, true>(ap, lds);
                    __syncthreads();
                    cmp_select((const bf16*)(ws + WS_IMPH), SEL, q0, lds, F.tid); }
            }
        }
        SEAM(pb + 5);
        STAMP(pb + 6);
        if (PHEN(6) && IN(pb + 6)) { PHASE_BEGIN
            unsigned* qctr = (unsigned*)(ws + WS_CTL) + CW_QUEUE + 64 * (L * 4 + 3);
            for (;;) { const int u = next_unit(qctr, lds); if (u >= 576) break; int b, c, slot; decode_slc(u, b, c, slot);
                att::AttnP ap; ap.q_pitch = NP; ap.kv_pitch = NP; ap.o_pitch = 512; ap.lse_pitch = 4; ap.q_tstride = 1; ap.k_tok0 = 0; ap.k_tstride = 1; ap.cum = nullptr; ap.bm = SEL;
                ap.Q = P + COL_DQ; ap.K = P + COL_DKS; ap.V = P + COL_DVS; ap.O = (bf16*)(ws + WS_PS) + ((ptrdiff_t)slot * 64 - 64 * b) * 512; ap.LSE = (float*)(ws + WS_LSES) + ((ptrdiff_t)slot * 64 - 64 * b) * 4;
                ap.q_tok0 = 64 * b; ap.q_sub0 = 64 * b; ap.j_lo = 16 * c; ap.j_hi = min(16 * c + 16, b + 1);
#ifdef HYB_TIME
                const unsigned long long t0_ = __builtin_amdgcn_s_memrealtime();
#endif
                att::attn_unit<att::M_SLC, true>(ap, lds);
#ifdef HYB_TIME
                if (L == 0 && blockIdx.x == 0 && threadIdx.x == 0) { unsigned long long* ts_ = (unsigned long long*)(ws + WS_CTL + 262144); ts_[50] += __builtin_amdgcn_s_memrealtime() - t0_; ts_[51] += (unsigned long long)(ap.j_hi - ap.j_lo); ts_[52] += 1ull; }
#endif
 }
        }
        SEAM(pb + 6);
        STAMP(pb + 7);
        if (PHEN(7) && IN(pb + 7)) { PHASE_BEGIN combine_phase(F, ws, BR); }
        SEAM(pb + 7);
        STAMP(pb + 8);
        if (PHEN(8) && IN(pb + 8)) { PHASE_BEGIN
            pg8::Gemm g{BR, WB, 4 * S, 4 * DM, 512, 512}; pg8::StackOrder So; So.init(32, 8, 4, F.G, (int)blockIdx.x);
            pg8::EpiPlain<0> E{Y, DM, 8, DM};
            pg8::gemm_phase<pg8::EpiPlain<0>, pg8::StackOrder, true, true>(F.lds, g, So, E);
        }
        SEAM(pb + 8);
        STAMP(pb + 9);
        if (PHEN(9) && IN(pb + 9)) { PHASE_BEGIN
            pg8::Gemm g{XN, WG, S, 8192, DM, DM}; pg8::StaticOrder So; So.init(S, 8192, F.G, (int)blockIdx.x);
            pg8::EpiGate E{Y, ka->in[4] + (size_t)L * 4 * DM, MG};
            pg8::gemm_phase<pg8::EpiGate, pg8::StaticOrder, true, true>(F.lds, g, So, E);
        }
        SEAM(pb + 9);
        STAMP(pb + 10);
        if (PHEN(10) && IN(pb + 10)) { PHASE_BEGIN
            pg8::Gemm g{MG, WO, S, DM, DM, DM}; pg8::StaticOrder So; So.init(S, DM, F.G, (int)blockIdx.x);
            pg8::EpiRes E{XIN, X1};
            pg8::gemm_phase<pg8::EpiRes, pg8::StaticOrder, true, true>(F.lds, g, So, E);
        }
        SEAM(pb + 10);
        STAMP(pb + 11);
        if (PHEN(11) && IN(pb + 11)) { PHASE_BEGIN
            transpose_all<MAP_FFI>(F, ka->in[12] + (size_t)L * DM * NFF2, DM, NFF2, NFF2, WFI);
            for (int m = F.gw; m < S; m += F.NGW) rms_row(X1 + (size_t)m * DM, ka->in[11] + (size_t)L * DM, XN + (size_t)m * DM, nullptr, F.lane); }
        SEAM(pb + 11);
        STAMP(pb + 12);
        if (PHEN(12) && IN(pb + 12)) { PHASE_BEGIN
            pg8::Gemm g{XN, WFI, S, NFF2, DM, DM}; pg8::StaticOrder So; So.init(S, NFF2, F.G, (int)blockIdx.x);
            pg8::EpiSwiglu E{ACT};
            pg8::gemm_phase<pg8::EpiSwiglu, pg8::StaticOrder, true, true>(F.lds, g, So, E);
            if (F.G != 256 || blockIdx.x >= 128) {
                __syncthreads();
                const int gw2 = F.G != 256 ? F.gw : ((int)blockIdx.x - 128) * NWAVES + F.wave, ngw2 = F.G != 256 ? F.NGW : 128 * NWAVES;
                transpose_some<MAP_ID>(F, gw2, ngw2, ka->in[13] + (size_t)L * NFF * DM, NFF, DM, DM, WFO);
                if (L == 0) transpose_some<MAP_IN>(F, gw2, ngw2, ka->in[2] + (size_t)1 * DM * 10080, DM, 10080, NP, WIN_);
            }
        }
        SEAM(pb + 12);
        STAMP(pb + 13);
        if (PHEN(13) && IN(pb + 13)) { PHASE_BEGIN
            pg8::Gemm g{ACT, WFO, S, DM, NFF, NFF}; pg8::StaticOrder So; So.init(S, DM, F.G, (int)blockIdx.x);
            pg8::EpiRes E{X1, X2};
            pg8::gemm_phase<pg8::EpiRes, pg8::StaticOrder, true, true>(F.lds, g, So, E);
        }
        SEAM(pb + 13);

    }
#ifdef HYB_PROBE_OFF
    {
        if (args.ph_hi > 0) SEAM_FORCE();
        CArgs ka = (CArgs)__builtin_amdgcn_kernarg_segment_ptr(); const bf16* src = (const bf16*)(ka->ws + (size_t)(HYB_PROBE_OFF));
        for (size_t i = (size_t)blockIdx.x * 512 + threadIdx.x; i < (size_t)S * DM; i += (size_t)gridDim.x * 512) { const size_t t = i / DM, c = i % DM; const size_t si = (t * (HYB_PROBE_PITCH) + c) % (size_t)(HYB_PROBE_MOD);
#ifdef HYB_PROBE_BM
            { const unsigned w = (unsigned)(c & 255); const unsigned v = (w < 8u * ((unsigned)(t >> 8) + 1u)) ? ((const unsigned*)src)[t * 256 + w] : 0u; ka->out[i] = (float)(v & 0xffffu) + (float)(v >> 16) * (1.0f / 65536.0f); (void)si; }
#elif defined(HYB_PROBE_F32)
            ka->out[i] = ((const float*)src)[si];
#elif defined(HYB_PROBE_U32)
            ka->out[i] = (float)(((const unsigned*)src)[si] & 0xffffu) + (float)(((const unsigned*)src)[si] >> 16) * (1.0f / 65536.0f);
#else
            ka->out[i] = bf2f(src[si]);
#endif
 }
        return;
    }
#endif
    STAMP(PH_FINAL);
#ifdef HYB_TIME
    if (PHEN(14) && IN(PH_FINAL)) { const int L = 1; (void)L; PHASE_BEGIN
        const unsigned long long* ts = (const unsigned long long*)(ws + WS_CTL + 262144);
        const float dA = (float)(ts[TIME_A1] - ts[TIME_A0]) * (0.01f / 2000.f);
#ifdef TIME_MINFIN
        const float dB = (float)(((1ull << 40) - ts[45]) - ts[TIME_B0]) * (0.01f / TIME_BDIV);
#elif defined(TIME_RATIO)
        const float dB = (float)ts[TIME_B1] / (float)ts[TIME_B0] * (1.f / TIME_BDIV);
#else
        const float dB = (float)(ts[TIME_B1] - ts[TIME_B0]) * (0.01f / TIME_BDIV);
#endif
        for (int m = F.gw; m < S; m += F.NGW) { rms_row(X2 + (size_t)m * DM, ka->in[14], nullptr, ka->out + (size_t)m * DM, F.lane);
            for (int c = F.lane; c < DM; c += 64) { float v = ka->out[(size_t)m * DM + c] * (1.f + dA); if (m == 0 && c == 0) v += dB; ka->out[(size_t)m * DM + c] = v; } }
    }
#else
    if (PHEN(14) && IN(PH_FINAL)) { const int L = 1; (void)L; PHASE_BEGIN for (int m = F.gw; m < S; m += F.NGW) rms_row(X2 + (size_t)m * DM, ka->in[14], nullptr, ka->out + (size_t)m * DM, F.lane);
#ifdef FINAL_TWICE
        for (int rep = 0; rep < 4; ++rep) { asm volatile("" ::: "memory"); for (int m = F.gw; m < S; m += F.NGW) rms_row(X2 + (size_t)m * DM, ka->in[14], nullptr, ka->out + (size_t)m * DM, F.lane); }
#endif
    }
#endif
#undef IN
#undef SEAM
}

#ifndef HYB_N_LAUNCHES
#define HYB_N_LAUNCHES 1
#endif
extern "C" void kernel_launch(void* const* d_in, const int* in_sizes, int n_in, void* d_out, int out_size, void* d_ws, size_t ws_size, hipStream_t stream) {
    static int grid = 0;
    if (grid == 0) {
        if (n_in != 15 || out_size != S * DM || ws_size < WS_END) { fprintf(stderr, "kernel_launch: unexpected shapes: n_in %d out %d ws %zu (need %zu)\n", n_in, out_size, ws_size, (size_t)WS_END); grid = -1; return; }
        int dev = 0, cus = 0, per_cu = 0;
        if (hipGetDevice(&dev) != hipSuccess || hipDeviceGetAttribute(&cus, hipDeviceAttributeMultiprocessorCount, dev) != hipSuccess) { grid = -1; return; }
        if (hipFuncSetAttribute((const void*)hyb_fwd, hipFuncAttributeMaxDynamicSharedMemorySize, LDS_BYTES) != hipSuccess) { fprintf(stderr, "kernel_launch: hipFuncSetAttribute failed\n"); grid = -1; return; }
        if (hipOccupancyMaxActiveBlocksPerMultiprocessor(&per_cu, (const void*)hyb_fwd, NWAVES * 64, LDS_BYTES) != hipSuccess || per_cu < 1) { fprintf(stderr, "kernel_launch: occupancy query says %d\n", per_cu); }
        (void)hipGetLastError();
        grid = cus;
    }
    if (grid < 0) return;
    if (hipMemsetAsync((char*)d_ws + WS_CTL, 0, CTL_ZERO_BYTES, stream) != hipSuccess) return;
    Args a{};
    for (int i = 0; i < 15; ++i) a.in[i] = (const float*)d_in[i];
    a.out = (float*)d_out; a.ws = (unsigned char*)d_ws; a.grid = grid; a.pad = 0;
#if HYB_N_LAUNCHES == 1
#ifndef HYB_PH_HI
#define HYB_PH_HI PH_END
#endif
    a.ph_lo = 0; a.ph_hi = HYB_PH_HI;
    hipLaunchKernelGGL(hyb_fwd, dim3(grid), dim3(NWAVES * 64), LDS_BYTES, stream, a);
#else
    for (int ph = 0; ph < PH_END; ++ph) { a.ph_lo = ph; a.ph_hi = ph + 1; hipLaunchKernelGGL(hyb_fwd, dim3(grid), dim3(NWAVES * 64), LDS_BYTES, stream, a); }
#endif
}
```
